# Optimizing an MI355X kernel written in HIP

```python
import math
import jax
import jax.numpy as jnp
from jax import lax
import numpy as np

D_MODEL = 1024
BATCH = 32
SEQ = 2048
DEPTH = 4

HEAD_DIM = 64
N_Q_HEADS = 8
N_KV_HEADS = 2
GROUP = N_Q_HEADS // N_KV_HEADS
WINDOW = 128
ATTN_BLOCK = WINDOW
Q_WIDTH = N_Q_HEADS * HEAD_DIM
KV_WIDTH = N_KV_HEADS * HEAD_DIM
NUM_BUCKETS = 32
MAX_DISTANCE = 128
CONV_CHANNELS = D_MODEL // 2
CONV_WIDTH = 31
EVEN_IN = Q_WIDTH + 2 * KV_WIDTH + 2 * CONV_CHANNELS
EVEN_CAT = Q_WIDTH + CONV_CHANNELS
LRU_WIDTH = D_MODEL
LRU_HEADS = 8
LRU_BLOCK = LRU_WIDTH // LRU_HEADS
LRU_CONV_WIDTH = 4
RG_LRU_C = 8.0
D_FF = 2816
RMS_EPS = 1e-6
LN_EPS = 1e-5
NEG_INF = -1e30
N_EVEN = (DEPTH + 1) // 2
N_ODD = DEPTH // 2

kernel_name = "hybrid_swa_conformer_rglru_macaron"


def _rmsnorm(x, g):
    xf = x.astype(jnp.float32)
    y = xf * lax.rsqrt(jnp.mean(xf * xf, axis=-1, keepdims=True) + RMS_EPS)
    return (y * g.astype(jnp.float32)).astype(x.dtype)


def _layernorm(x, g, b):
    xf = x.astype(jnp.float32)
    mu = jnp.mean(xf, axis=-1, keepdims=True)
    var = jnp.mean(jnp.square(xf - mu), axis=-1, keepdims=True)
    y = (xf - mu) * lax.rsqrt(var + LN_EPS)
    return (y * g.astype(jnp.float32) + b.astype(jnp.float32)).astype(x.dtype)


def _swiglu(x, wg, wu, wd):
    return (jax.nn.silu(x @ wg) * (x @ wu)) @ wd


def _causal_depthwise_conv(x, w, b):
    k_width, chans = w.shape
    y = lax.conv_general_dilated(
        x, w[:, None, :].astype(x.dtype), window_strides=(1,),
        padding=[(k_width - 1, 0)], dimension_numbers=("NWC", "WIO", "NWC"),
        feature_group_count=chans)
    return y + b.astype(x.dtype)


def _t5_bucket(dist):
    n = jnp.maximum(dist, 0)
    max_exact = NUM_BUCKETS // 2
    nf = jnp.maximum(n, max_exact).astype(jnp.float32)
    large = max_exact + (jnp.log(nf / max_exact) / math.log(MAX_DISTANCE / max_exact)
                         * (NUM_BUCKETS - max_exact)).astype(jnp.int32)
    large = jnp.minimum(large, NUM_BUCKETS - 1)
    return jnp.where(n < max_exact, n, large)


def _swa_sink_attention(q, k, v, sinks, rel_bias):
    bsz, seq = q.shape[:2]
    nb = seq // ATTN_BLOCK
    qb = q.reshape(bsz, nb, ATTN_BLOCK, N_KV_HEADS, GROUP, HEAD_DIM)
    kb = k.reshape(bsz, nb, ATTN_BLOCK, N_KV_HEADS, HEAD_DIM)
    vb = v.reshape(bsz, nb, ATTN_BLOCK, N_KV_HEADS, HEAD_DIM)
    kk = jnp.concatenate([jnp.concatenate([jnp.zeros_like(kb[:, :1]), kb[:, :-1]], axis=1), kb], axis=2)
    vv = jnp.concatenate([jnp.concatenate([jnp.zeros_like(vb[:, :1]), vb[:, :-1]], axis=1), vb], axis=2)
    scores = jnp.einsum("bnqhgd,bnshd->bnhgqs", qb, kk,
                        preferred_element_type=jnp.float32) * (1.0 / math.sqrt(HEAD_DIM))
    qi = jnp.arange(ATTN_BLOCK)[:, None]
    sj = jnp.arange(2 * ATTN_BLOCK)[None, :]
    dist = qi + ATTN_BLOCK - sj
    bias = rel_bias.astype(jnp.float32)[_t5_bucket(dist)]
    bias = jnp.transpose(bias, (2, 0, 1)).reshape(N_KV_HEADS, GROUP, ATTN_BLOCK, 2 * ATTN_BLOCK)
    in_window = (dist >= 0) & (dist < WINDOW)
    key_pos = jnp.arange(nb)[:, None, None] * ATTN_BLOCK + sj[None] - ATTN_BLOCK
    mask = in_window[None] & (key_pos >= 0)
    scores = jnp.where(mask[None, :, None, None], scores + bias[None, None], NEG_INF)
    sink = sinks.astype(jnp.float32).reshape(N_KV_HEADS, GROUP)[None, None, :, :, None, None]
    sink = jnp.broadcast_to(sink, scores.shape[:-1] + (1,))
    probs = jax.nn.softmax(jnp.concatenate([scores, sink], axis=-1), axis=-1)[..., :-1]
    out = jnp.einsum("bnhgqs,bnshd->bnqhgd", probs.astype(v.dtype), vv)
    return out.reshape(bsz, seq, Q_WIDTH)


def _attn_conv_mixer(h, w_in, sinks, conv_w, conv_b, ln_g, ln_b, w_out, rel_bias):
    bsz, seq, _ = h.shape
    u = h @ w_in
    o1 = Q_WIDTH
    o2 = o1 + KV_WIDTH
    o3 = o2 + KV_WIDTH
    o4 = o3 + CONV_CHANNELS
    q = u[..., :o1].reshape(bsz, seq, N_Q_HEADS, HEAD_DIM)
    k = u[..., o1:o2].reshape(bsz, seq, N_KV_HEADS, HEAD_DIM)
    v = u[..., o2:o3].reshape(bsz, seq, N_KV_HEADS, HEAD_DIM)
    attn = _swa_sink_attention(q, k, v, sinks, rel_bias)
    glu = u[..., o3:o4] * jax.nn.sigmoid(u[..., o4:])
    c = jax.nn.silu(_layernorm(_causal_depthwise_conv(glu, conv_w, conv_b), ln_g, ln_b))
    return jnp.concatenate([attn, c], axis=-1) @ w_out


def _rg_lru(x, ga_w, ga_b, gx_w, gx_b, lam):
    bsz, seq, width = x.shape
    xh = x.reshape(bsz, seq, LRU_HEADS, LRU_BLOCK)
    r = jax.nn.sigmoid(jnp.einsum("bshi,hij->bshj", xh, ga_w).reshape(bsz, seq, width) + ga_b)
    i = jax.nn.sigmoid(jnp.einsum("bshi,hij->bshj", xh, gx_w).reshape(bsz, seq, width) + gx_b)
    log_a = RG_LRU_C * r.astype(jnp.float32) * jax.nn.log_sigmoid(lam.astype(jnp.float32))
    a = jnp.exp(log_a)
    bx = jnp.sqrt(-jnp.expm1(2.0 * log_a)) * (i * x).astype(jnp.float32)

    def combine(left, right):
        a1, b1 = left
        a2, b2 = right
        return a1 * a2, a2 * b1 + b2

    _, hs = lax.associative_scan(combine, (a, bx), axis=1)
    return hs.astype(x.dtype)


def _recurrent_mixer(h, w_in, conv_w, conv_b, ga_w, ga_b, gx_w, gx_b, lam, w_out):
    u = h @ w_in
    gate = jax.nn.gelu(u[..., :LRU_WIDTH])
    rec = _causal_depthwise_conv(u[..., LRU_WIDTH:], conv_w, conv_b)
    rec = _rg_lru(rec, ga_w, ga_b, gx_w, gx_b, lam)
    return (gate * rec) @ w_out


def setup_inputs(seed: int = 0) -> dict:
    key = jax.random.key(seed)
    ks = iter(jax.random.split(key, 40))

    def nrm(shape, scale):
        return jax.random.normal(next(ks), shape, jnp.float32) * scale

    def gain(shape):
        return 1.0 + nrm(shape, 0.02)

    x = nrm((BATCH, SEQ, D_MODEL), 1.0)
    u = jax.random.uniform(next(ks), (N_ODD, LRU_WIDTH), jnp.float32, 0.9, 0.999)
    a0 = u ** (1.0 / RG_LRU_C)
    lru_lambda = jnp.log(a0) - jnp.log1p(-a0)
    return {
        "x": x,
        "norm_ffn1": gain((DEPTH, D_MODEL)),
        "ffn1_wg": nrm((DEPTH, D_MODEL, D_FF), D_MODEL ** -0.5),
        "ffn1_wu": nrm((DEPTH, D_MODEL, D_FF), D_MODEL ** -0.5),
        "ffn1_wd": nrm((DEPTH, D_FF, D_MODEL), D_FF ** -0.5),
        "norm_mix": gain((DEPTH, D_MODEL)),
        "norm_ffn2": gain((DEPTH, D_MODEL)),
        "ffn2_wg": nrm((DEPTH, D_MODEL, D_FF), D_MODEL ** -0.5),
        "ffn2_wu": nrm((DEPTH, D_MODEL, D_FF), D_MODEL ** -0.5),
        "ffn2_wd": nrm((DEPTH, D_FF, D_MODEL), D_FF ** -0.5),
        "rel_bias": nrm((NUM_BUCKETS, N_Q_HEADS), 0.3),
        "even_w_in": nrm((N_EVEN, D_MODEL, EVEN_IN), D_MODEL ** -0.5),
        "attn_sinks": nrm((N_EVEN, N_Q_HEADS), 1.0),
        "conv_b_w": nrm((N_EVEN, CONV_WIDTH, CONV_CHANNELS), CONV_WIDTH ** -0.5),
        "conv_b_b": nrm((N_EVEN, CONV_CHANNELS), 0.02),
        "conv_ln_g": gain((N_EVEN, CONV_CHANNELS)),
        "conv_ln_b": nrm((N_EVEN, CONV_CHANNELS), 0.02),
        "even_w_out": nrm((N_EVEN, EVEN_CAT, D_MODEL), EVEN_CAT ** -0.5),
        "odd_w_in": nrm((N_ODD, D_MODEL, 2 * LRU_WIDTH), D_MODEL ** -0.5),
        "lru_conv_w": nrm((N_ODD, LRU_CONV_WIDTH, LRU_WIDTH), LRU_CONV_WIDTH ** -0.5),
        "lru_conv_b": nrm((N_ODD, LRU_WIDTH), 0.02),
        "gate_a_w": nrm((N_ODD, LRU_HEADS, LRU_BLOCK, LRU_BLOCK), LRU_BLOCK ** -0.5),
        "gate_a_b": nrm((N_ODD, LRU_WIDTH), 0.02),
        "gate_x_w": nrm((N_ODD, LRU_HEADS, LRU_BLOCK, LRU_BLOCK), LRU_BLOCK ** -0.5),
        "gate_x_b": nrm((N_ODD, LRU_WIDTH), 0.02),
        "lru_lambda": lru_lambda,
        "odd_w_out": nrm((N_ODD, LRU_WIDTH, D_MODEL), LRU_WIDTH ** -0.5),
        "norm_final": gain((D_MODEL,)),
    }


def reference(x, norm_ffn1, ffn1_wg, ffn1_wu, ffn1_wd, norm_mix, norm_ffn2, ffn2_wg, ffn2_wu, ffn2_wd,
              rel_bias, even_w_in, attn_sinks, conv_b_w, conv_b_b, conv_ln_g, conv_ln_b, even_w_out,
              odd_w_in, lru_conv_w, lru_conv_b, gate_a_w, gate_a_b, gate_x_w, gate_x_b, lru_lambda,
              odd_w_out, norm_final):
    h = x
    for layer in range(DEPTH):
        h = h + 0.5 * _swiglu(_rmsnorm(h, norm_ffn1[layer]), ffn1_wg[layer], ffn1_wu[layer], ffn1_wd[layer])
        hn = _rmsnorm(h, norm_mix[layer])
        if layer % 2 == 0:
            e = layer // 2
            h = h + _attn_conv_mixer(hn, even_w_in[e], attn_sinks[e], conv_b_w[e], conv_b_b[e],
                                     conv_ln_g[e], conv_ln_b[e], even_w_out[e], rel_bias)
        else:
            o = layer // 2
            h = h + _recurrent_mixer(hn, odd_w_in[o], lru_conv_w[o], lru_conv_b[o], gate_a_w[o],
                                     gate_a_b[o], gate_x_w[o], gate_x_b[o], lru_lambda[o], odd_w_out[o])
        h = h + 0.5 * _swiglu(_rmsnorm(h, norm_ffn2[layer]), ffn2_wg[layer], ffn2_wu[layer], ffn2_wd[layer])
    return _rmsnorm(h, norm_final)
```

```cpp
#include <hip/hip_runtime.h>
#include <hip/hip_cooperative_groups.h>
#include <cstdio>
#include <cstdint>
namespace cg = cooperative_groups;

#define LAS __attribute__((address_space(3)))
#define GAS __attribute__((address_space(1)))
typedef unsigned short bf16_t;
typedef short bf16x8 __attribute__((ext_vector_type(8)));
typedef float f32x4 __attribute__((ext_vector_type(4)));
typedef float f32x16 __attribute__((ext_vector_type(16)));
typedef unsigned u32x4 __attribute__((ext_vector_type(4)));
typedef unsigned u32x2 __attribute__((ext_vector_type(2)));

constexpr int DM = 1024, NB = 32, SEQ = 2048, MTOK = NB * SEQ, DFF = 2816;
constexpr int NGU = 2 * DFF;
constexpr int EVEN_IN = 1792;
constexpr float RMS_EPS = 1e-6f, LN_EPS = 1e-5f;

constexpr size_t MiB = 1u << 20;
constexpr size_t WS_FFN = 0;
constexpr size_t FFN_STRIDE = 16 * MiB + MiB / 2, WGU_BYTES = 11 * MiB;
constexpr size_t WS_EVEN = 132 * MiB, EVEN_STRIDE = 5 * MiB + MiB / 2, EVEN_WIN_BYTES = 3 * MiB + MiB / 2;
constexpr size_t WS_ODD = 143 * MiB, ODD_STRIDE = 7 * MiB;
constexpr size_t WS_TAB = 157 * MiB;
constexpr size_t WS_BAR = 157 * MiB + 64 * 1024;
constexpr size_t WS_SSQ = 158 * MiB;
constexpr size_t WS_HB = 164 * MiB;
constexpr size_t WS_SCR = 292 * MiB;
constexpr size_t WS_MID = WS_SCR;
constexpr size_t WS_Q = WS_SCR, WS_KV = WS_SCR + 64 * MiB, WS_GLU = WS_SCR + 96 * MiB, WS_CAT = WS_SCR + 160 * MiB;
constexpr size_t WS_GATE = WS_SCR, WS_UREC = WS_SCR + 128 * MiB, WS_XC = WS_SCR + 256 * MiB, WS_A = WS_SCR + 384 * MiB;
constexpr size_t WS_NEED = WS_A + 256 * MiB;
static_assert(WS_NEED <= 1024 * MiB, "ws map");

constexpr int LDS_BYTES = 147456;

#ifndef USE_FP16
#define USE_FP16 1
#endif
typedef _Float16 h16x2 __attribute__((ext_vector_type(2)));
typedef _Float16 h16x8 __attribute__((ext_vector_type(8)));
#if USE_FP16
__device__ __forceinline__ unsigned cvt_pk_bf16(float lo, float hi) { h16x2 v; v.x = (_Float16)lo; v.y = (_Float16)hi; return __builtin_bit_cast(unsigned, v); }
__device__ __forceinline__ unsigned cvt_pk_rtz(float lo, float hi) { return __builtin_bit_cast(unsigned, __builtin_amdgcn_cvt_pkrtz(lo, hi)); }
__device__ __forceinline__ float bf_lo(unsigned w) { return (float)__builtin_bit_cast(h16x2, w).x; }
__device__ __forceinline__ float bf_hi(unsigned w) { return (float)__builtin_bit_cast(h16x2, w).y; }
__device__ __forceinline__ float bf2f(bf16_t b) { return (float)__builtin_bit_cast(_Float16, b); }
#define MFMA16(a, b, c) __builtin_amdgcn_mfma_f32_16x16x32_f16(__builtin_bit_cast(h16x8, a), __builtin_bit_cast(h16x8, b), c, 0, 0, 0)
#define MFMA32(a, b, c) __builtin_amdgcn_mfma_f32_32x32x16_f16(__builtin_bit_cast(h16x8, a), __builtin_bit_cast(h16x8, b), c, 0, 0, 0)
#else
typedef float cvt_f32x2_t __attribute__((ext_vector_type(2))); typedef __bf16 cvt_bf16x2_t __attribute__((ext_vector_type(2)));
__device__ __forceinline__ unsigned cvt_pk_bf16(float lo, float hi) { const cvt_f32x2_t v = {lo, hi}; return __builtin_bit_cast(unsigned, __builtin_convertvector(v, cvt_bf16x2_t)); }
__device__ __forceinline__ unsigned cvt_pk_rtz(float lo, float hi) { return cvt_pk_bf16(lo, hi); }
__device__ __forceinline__ float bf_lo(unsigned w) { return __uint_as_float(w << 16); }
__device__ __forceinline__ float bf_hi(unsigned w) { return __uint_as_float(w & 0xffff0000u); }
__device__ __forceinline__ float bf2f(bf16_t b) { return __uint_as_float((unsigned)b << 16); }
#define MFMA16(a, b, c) __builtin_amdgcn_mfma_f32_16x16x32_bf16(a, b, c, 0, 0, 0)
#define MFMA32(a, b, c) __builtin_amdgcn_mfma_f32_32x32x16_bf16(a, b, c, 0, 0, 0)
#endif
#if USE_FP16
__device__ __forceinline__ float round_bf16_f(float v) { return __uint_as_float((unsigned)__builtin_bit_cast(unsigned short, (__bf16)v) << 16); }
__device__ __forceinline__ unsigned cvt_pk_w(float lo, float hi) { return cvt_pk_bf16(round_bf16_f(lo), round_bf16_f(hi)); }
#else
__device__ __forceinline__ unsigned cvt_pk_w(float lo, float hi) { return cvt_pk_bf16(lo, hi); }
#endif
__device__ __forceinline__ float sigmoid_f(float x) { return __builtin_amdgcn_rcpf(1.0f + __expf(-x)); }
__device__ __forceinline__ float silu_f(float x) { return x * sigmoid_f(x); }
__device__ __forceinline__ float gelu_tanh_f(float x) { const float z = 0.7978845608028654f * (x + 0.044715f * x * x * x); return x * sigmoid_f(2.0f * z); }
template <int MASK> __device__ __forceinline__ float swz_xor(float v) { return __int_as_float(__builtin_amdgcn_ds_swizzle(__float_as_int(v), (MASK << 10) | 0x1F)); }
__device__ __forceinline__ float sum_x32(float v) { const auto rr = __builtin_amdgcn_permlane32_swap(__float_as_uint(v), __float_as_uint(v), false, false); return __uint_as_float(rr[0]) + __uint_as_float(rr[1]); }
__device__ __forceinline__ float max_x32(float v) { const auto rr = __builtin_amdgcn_permlane32_swap(__float_as_uint(v), __float_as_uint(v), false, false); return fmaxf(__uint_as_float(rr[0]), __uint_as_float(rr[1])); }
__device__ __forceinline__ float wave_sum(float v) {
    v += swz_xor<1>(v); v += swz_xor<2>(v); v += swz_xor<4>(v); v += swz_xor<8>(v); v += swz_xor<16>(v);
    return sum_x32(v);
}
__device__ __forceinline__ u32x4 pack8(const f32x4 a, const f32x4 b) { u32x4 w; w.x = cvt_pk_rtz(a[0], a[1]); w.y = cvt_pk_rtz(a[2], a[3]); w.z = cvt_pk_rtz(b[0], b[1]); w.w = cvt_pk_rtz(b[2], b[3]); return w; }
__device__ __forceinline__ u32x4 pack8_rne(const f32x4 a, const f32x4 b) { u32x4 w; w.x = cvt_pk_bf16(a[0], a[1]); w.y = cvt_pk_bf16(a[2], a[3]); w.z = cvt_pk_bf16(b[0], b[1]); w.w = cvt_pk_bf16(b[2], b[3]); return w; }

__device__ __forceinline__ int lane_id_asm() { int l; asm volatile("v_mbcnt_lo_u32_b32 %0, -1, 0\n\tv_mbcnt_hi_u32_b32 %0, -1, %0" : "=v"(l)); return l; }

namespace pg8 {
constexpr int BM = 256, BK = 64, HALF = 128, HTB = HALF * BK * 2, STAGE_BYTES = 8 * HTB, NXCD = 8, WGM = 8;
__host__ __device__ __forceinline__ int lds_byte(int r, int c) { const int st = (r >> 4) * 2 + (c >> 5), rr = r & 15, cc = c & 31, ob = rr * 64 + cc * 2; return st * 1024 + (ob ^ (((ob >> 9) & 1) << 5)); }
__host__ __device__ __forceinline__ void stage_rc(int b, int& R, int& C) { const int st = b / 1024, sb = b % 1024, swz = sb ^ (((sb >> 9) & 1) << 5); R = (st >> 1) * 16 + swz / 64; C = (st & 1) * 32 + (swz % 64) / 2; }
__host__ __device__ __forceinline__ int perm32(int rho) { const int n = rho >> 4, i = rho & 15; return 8 * (i >> 2) + 4 * n + (i & 3); }

struct Unit { int pm, pn; };
struct Gemm { const bf16_t* A; const bf16_t* Bt; int M, N, K, lda, ldb, acol_step; };

struct StaticOrder {
    int nM, nN, nwg, G, c;
    __host__ __device__ void init(int M, int N, int G_, int c_) { nM = M / BM; nN = N / BM; nwg = nM * nN; G = G_; c = c_; }
    __host__ __device__ bool next(int i, Unit& u) const {
        const long L = (long)i * G + c; if (L >= nwg) return false;
        int wgid = (int)L; { const int q = nwg / NXCD, r = nwg % NXCD, xcd = wgid % NXCD, off = wgid / NXCD; wgid = (xcd < r ? xcd * (q + 1) : r * (q + 1) + (xcd - r) * q) + off; }
        const int nig = WGM * nN, gid = wgid / nig, fm = gid * WGM, gsz = (nM - fm) < WGM ? (nM - fm) : WGM;
        u.pm = fm + ((wgid % nig) % gsz); u.pn = (wgid % nig) / gsz; return true;
    }
};

template <class Epi>
__device__ __forceinline__ void gemm_phase(LAS unsigned char* lds, const Gemm g, const StaticOrder& S, const Epi& E, int tid_) {
    asm volatile("" : "+v"(tid_));
    const int tid = tid_, wid = __builtin_amdgcn_readfirstlane(tid >> 6), lane = tid & 63, wr = wid >> 2, wc = wid & 3, fr = lane & 15, fq = lane >> 4;
    int nt_ = g.K / BK; asm volatile("" : "+s"(nt_));
    const int nt = nt_;
    unsigned voffA[2], voffB[2];
#pragma unroll
    for (int i = 0; i < 2; ++i) { int R, C; stage_rc(tid * 16 + i * 8192, R, C); const int Rb = (R & ~31) + perm32(R & 31);
        voffA[i] = (unsigned)(R * g.lda + C) * 2u; voffB[i] = (unsigned)(Rb * g.ldb + C) * 2u; }
    const size_t kstep = (size_t)(BK * 2);
    const size_t hsA = (size_t)HALF * g.lda * 2, hsB = (size_t)HALF * g.ldb * 2;
    const size_t tsA = 2 * hsA, tsB = 2 * hsB;
    const unsigned ldsw = (unsigned)wid * 1024u;
    const int aoff = lds_byte(wr * 64 + fr, fq * 8), boff = lds_byte(wc * 32 + fr, fq * 8);
#define PG8_SA(b, h) (((b) * 2 + (h)) * HTB)
#define PG8_SB(b, h) ((4 + (b) * 2 + (h)) * HTB)
#define PG8_STAGE(bufoff, gbase, voff) do { _Pragma("unroll") for (int _i = 0; _i < 2; ++_i) \
        __builtin_amdgcn_global_load_lds((const unsigned*)((const char*)(gbase) + (voff)[_i]), (LAS unsigned*)(lds + (bufoff) + ldsw + _i * 8192), 16, 0, 0); } while (0)
#define PG8_LDA(dst, b, h) do { _Pragma("unroll") for (int m = 0; m < 4; ++m) _Pragma("unroll") for (int k = 0; k < 2; ++k) dst[m][k] = *(const LAS bf16x8*)(lds + PG8_SA(b, h) + aoff + m * 2048 + k * 1024); } while (0)
#define PG8_LDB(dst, b, h) do { _Pragma("unroll") for (int n = 0; n < 2; ++n) _Pragma("unroll") for (int k = 0; k < 2; ++k) dst[n][k] = *(const LAS bf16x8*)(lds + PG8_SB(b, h) + boff + n * 2048 + k * 1024); } while (0)
#define PG8_MMA(ai, bj, At, Bt) do { __builtin_amdgcn_s_setprio(1); _Pragma("unroll") for (int m = 0; m < 4; ++m) _Pragma("unroll") for (int n = 0; n < 2; ++n) _Pragma("unroll") for (int k = 0; k < 2; ++k) \
        acc[ai][bj][m][n] = MFMA16(Bt[n][k], At[m][k], acc[ai][bj][m][n]); __builtin_amdgcn_s_setprio(0); } while (0)
#define PG8_WAIT_V(n) asm volatile("s_waitcnt vmcnt(" #n ")" ::: "memory")
#define PG8_WAIT_L(n) asm volatile("s_waitcnt lgkmcnt(" #n ")" ::: "memory")
#define PG8_BAR __builtin_amdgcn_s_barrier()
#define PG8_SCHED __builtin_amdgcn_sched_barrier(0)
    Unit cur, nxt; int ui = 0;
    if (!S.next(0, cur)) return;
    LAS float* rcache = (LAS float*)(lds + STAGE_BYTES) + wid * 128;
    int cached_pm = -1;
    f32x4 acc[2][2][4][2];
#pragma unroll
    for (int a = 0; a < 2; ++a)
#pragma unroll
        for (int b = 0; b < 2; ++b)
#pragma unroll
            for (int m = 0; m < 4; ++m)
#pragma unroll
                for (int n = 0; n < 2; ++n) acc[a][b][m][n] = (f32x4){0.f, 0.f, 0.f, 0.f};
    bf16x8 At[4][2], B0[2][2], B1[2][2];
    const char* cA = (const char*)g.A + (size_t)cur.pm * tsA + (size_t)cur.pn * g.acol_step; const char* cB = (const char*)g.Bt + (size_t)cur.pn * tsB;
    PG8_STAGE(PG8_SB(0, 0), cB, voffB); PG8_STAGE(PG8_SB(0, 1), cB + hsB, voffB); PG8_STAGE(PG8_SA(0, 0), cA, voffA); PG8_STAGE(PG8_SA(0, 1), cA + hsA, voffA);
    if (wr == 1) PG8_BAR;
    PG8_WAIT_V(2); PG8_BAR;
    PG8_STAGE(PG8_SB(1, 0), cB + kstep, voffB); PG8_STAGE(PG8_SA(1, 0), cA + kstep, voffA); PG8_STAGE(PG8_SB(1, 1), cB + hsB + kstep, voffB);
    PG8_WAIT_V(6); PG8_BAR;
    for (;;) {
        const bool has_next = S.next(ui + 1, nxt);
        const char* nA = has_next ? (const char*)g.A + (size_t)nxt.pm * tsA + (size_t)nxt.pn * g.acol_step : cA; const char* nB = has_next ? (const char*)g.Bt + (size_t)nxt.pn * tsB : cB;
#pragma unroll 1
        for (int t = 0; t < nt; t += 2) {
            const bool last = (t == nt - 2);
            const char* a1 = cA + (size_t)(t + 1) * kstep;
            const char* a2 = last ? nA : cA + (size_t)(t + 2) * kstep; const char* b2 = last ? nB : cB + (size_t)(t + 2) * kstep;
            const char* a3 = a2 + kstep; const char* b3 = b2 + kstep;
            PG8_LDB(B0, 0, 0); PG8_LDB(B1, 0, 1); PG8_SCHED; PG8_LDA(At, 0, 0); PG8_STAGE(PG8_SA(1, 1), a1 + hsA, voffA);
            PG8_WAIT_V(8); PG8_WAIT_L(0); PG8_BAR; PG8_MMA(0, 0, At, B0); PG8_MMA(0, 1, At, B1); PG8_BAR; PG8_SCHED;
            PG8_LDA(At, 0, 1); PG8_STAGE(PG8_SB(0, 0), b2, voffB); PG8_STAGE(PG8_SB(0, 1), b2 + hsB, voffB); PG8_STAGE(PG8_SA(0, 0), a2, voffA);
            PG8_WAIT_V(8); PG8_WAIT_L(0); PG8_BAR; PG8_MMA(1, 0, At, B0); PG8_MMA(1, 1, At, B1); PG8_BAR; PG8_SCHED;
            PG8_LDB(B0, 1, 0); PG8_LDB(B1, 1, 1); PG8_SCHED; PG8_LDA(At, 1, 0); PG8_STAGE(PG8_SA(0, 1), a2 + hsA, voffA);
            PG8_WAIT_V(8); PG8_WAIT_L(0); PG8_BAR; PG8_MMA(0, 0, At, B0); PG8_MMA(0, 1, At, B1); PG8_BAR; PG8_SCHED;
            PG8_LDA(At, 1, 1); PG8_STAGE(PG8_SB(1, 0), b3, voffB); PG8_STAGE(PG8_SB(1, 1), b3 + hsB, voffB); PG8_STAGE(PG8_SA(1, 0), a3, voffA);
            PG8_WAIT_V(8); PG8_WAIT_L(0); PG8_BAR; PG8_MMA(1, 0, At, B0); PG8_MMA(1, 1, At, B1); PG8_BAR; PG8_SCHED;
        }
        if (wr == 0) PG8_BAR;
        E(acc, cur, wr, wc, fr, fq, rcache, cached_pm);
        if (!has_next) break;
#pragma unroll
        for (int a = 0; a < 2; ++a)
#pragma unroll
            for (int b = 0; b < 2; ++b)
#pragma unroll
                for (int m = 0; m < 4; ++m)
#pragma unroll
                    for (int n = 0; n < 2; ++n) acc[a][b][m][n] = (f32x4){0.f, 0.f, 0.f, 0.f};
        cur = nxt; cA = nA; cB = nB; ++ui;
        if (wr == 1) PG8_BAR;
    }
    PG8_WAIT_V(0);
    PG8_BAR;
#undef PG8_SA
#undef PG8_SB
#undef PG8_STAGE
#undef PG8_LDA
#undef PG8_LDB
#undef PG8_MMA
#undef PG8_WAIT_V
#undef PG8_WAIT_L
#undef PG8_BAR
#undef PG8_SCHED
}
}

typedef f32x4 Acc[2][2][4][2];
template <class T> __device__ __forceinline__ T* at(const void* base, unsigned byteoff) { return (T*)((char*)base + byteoff); }

__device__ __forceinline__ float row_rstd(const float* ssq, int row, int fq) {
    const f32x4 v = *at<const f32x4>(ssq, (unsigned)(row * 16 + fq * 4) * 4u);
    float s = (v[0] + v[1]) + (v[2] + v[3]);
    s += swz_xor<16>(s); s = sum_x32(s);
    return rsqrtf(s * (1.0f / 1024.0f) + RMS_EPS);
}

__device__ __forceinline__ void load_rstd8(const float* ssq, int row0, int fq, float (&rs)[8]) {
    f32x4 v[8];
#pragma unroll
    for (int i = 0; i < 8; ++i) v[i] = *at<const f32x4>(ssq, (unsigned)((row0 + (i >> 2) * 128 + (i & 3) * 16) * 16 + fq * 4) * 4u);
#pragma unroll
    for (int i = 0; i < 8; ++i) { float t = (v[i][0] + v[i][1]) + (v[i][2] + v[i][3]); t += swz_xor<16>(t); t = sum_x32(t); rs[i] = rsqrtf(t * (1.0f / 1024.0f) + RMS_EPS); }
}

__device__ __forceinline__ void get_rstd8(const float* ssq, int pm, int row0, int fr, int fq, LAS float* rcache, int& cached_pm, float (&rs)[8]) {
    if (pm == cached_pm) {
#pragma unroll
        for (int i = 0; i < 8; ++i) rs[i] = rcache[i * 16 + fr];
    } else {
        load_rstd8(ssq, row0, fq, rs);
        if (fq == 0) {
#pragma unroll
            for (int i = 0; i < 8; ++i) rcache[i * 16 + fr] = rs[i];
        }
        cached_pm = pm;
    }
}

struct EpiGU {
    bf16_t* O; const float* ssq;
    __device__ __forceinline__ void operator()(const Acc& acc, const pg8::Unit& u, int wr, int wc, int fr, int fq, LAS float* rcache, int& cached_pm) const {
        const int row0 = u.pm * 256 + wr * 64 + fr, col0 = u.pn * 128 + wc * 32 + 8 * fq;
        float rs8[8]; get_rstd8(ssq, u.pm, row0, fr, fq, rcache, cached_pm, rs8);
#pragma unroll
        for (int ai = 0; ai < 2; ++ai)
#pragma unroll
            for (int m = 0; m < 4; ++m) {
                const int row = row0 + ai * 128 + m * 16; const float rs = rs8[ai * 4 + m], nrl = rs * -1.4426950408889634f, rs2 = rs * rs;
                f32x4 o[2];
#pragma unroll
                for (int n = 0; n < 2; ++n) { const f32x4 gv = acc[ai][0][m][n], uv = acc[ai][1][m][n]; const f32x4 t = gv * nrl; f32x4 e;
#pragma unroll
                    for (int j = 0; j < 4; ++j) e[j] = __builtin_amdgcn_exp2f(t[j]);
                    e = e + 1.0f; f32x4 r;
#pragma unroll
                    for (int j = 0; j < 4; ++j) r[j] = __builtin_amdgcn_rcpf(e[j]);
                    o[n] = ((gv * uv) * rs2) * r; }
#if USE_FP16
                *at<u32x4>(O, (unsigned)(row * DFF + col0) * 2u) = pack8(o[0], o[1]) & 0xFFF8FFF8u;
#else
                __builtin_nontemporal_store(pack8(o[0], o[1]), at<u32x4>(O, (unsigned)(row * DFF + col0) * 2u));
#endif
            }
    }
};

struct EpiRes {
    bf16_t* hb; float* ssq; float scale;
    __device__ __forceinline__ void operator()(const Acc& acc, const pg8::Unit& u, int wr, int wc, int fr, int fq, LAS float* rcache, int& cached_pm) const {
        const int row0 = u.pm * 256 + wr * 64 + fr, col0 = u.pn * 256 + wc * 32 + 8 * fq;
#pragma unroll
        for (int ai = 0; ai < 2; ++ai) {
            u32x4 rw[4][2];
#pragma unroll
            for (int m = 0; m < 4; ++m)
#pragma unroll
                for (int bj = 0; bj < 2; ++bj) rw[m][bj] = *at<const u32x4>(hb, (unsigned)((row0 + ai * 128 + m * 16) * DM + col0 + bj * 128) * 2u);
#pragma unroll
            for (int m = 0; m < 4; ++m) {
                const int row = row0 + ai * 128 + m * 16; const unsigned off = (unsigned)(row * DM + col0); float ss = 0.f;
#pragma unroll
                for (int bj = 0; bj < 2; ++bj) {
                    const u32x4 w = rw[m][bj];
                    const f32x4 r0 = (f32x4){bf_lo(w.x), bf_hi(w.x), bf_lo(w.y), bf_hi(w.y)}, r1 = (f32x4){bf_lo(w.z), bf_hi(w.z), bf_lo(w.w), bf_hi(w.w)};
                    const f32x4 v0 = r0 + acc[ai][bj][m][0] * scale, v1 = r1 + acc[ai][bj][m][1] * scale;
                    *at<u32x4>(hb, (off + bj * 128) * 2u) = pack8_rne(v0, v1);
                    ss += (v0[0] * v0[0] + v0[1] * v0[1]) + (v0[2] * v0[2] + v0[3] * v0[3]) + (v1[0] * v1[0] + v1[1] * v1[1]) + (v1[2] * v1[2] + v1[3] * v1[3]);
                }
                ss += swz_xor<16>(ss); ss = sum_x32(ss);
                if (fq == 0) *at<float>(ssq, (unsigned)(row * 16 + u.pn * 4 + wc) * 4u) = ss;
            }
        }
    }
};

struct EpiEvenIn {
    bf16_t* q; bf16_t* kv; bf16_t* glu; const float* ssq;
    __device__ __forceinline__ void operator()(const Acc& acc, const pg8::Unit& u, int wr, int wc, int fr, int fq, LAS float* rcache, int& cached_pm) const {
        const int row0 = u.pm * 256 + wr * 64 + fr, cl = wc * 32 + 8 * fq, pn = u.pn;
        float rs8[8]; get_rstd8(ssq, u.pm, row0, fr, fq, rcache, cached_pm, rs8);
        if (pn < 3) {
            bf16_t* base = pn < 2 ? q + pn * 256 : kv; const int ld = pn < 2 ? 512 : 256; const float sc = pn < 2 ? 0.125f * 1.4426950408889634f : 1.0f;
#pragma unroll
            for (int ai = 0; ai < 2; ++ai)
#pragma unroll
                for (int m = 0; m < 4; ++m) {
                    const int row = row0 + ai * 128 + m * 16; const float s = rs8[ai * 4 + m] * sc;
#pragma unroll
                    for (int bj = 0; bj < 2; ++bj) *at<u32x4>(base, (unsigned)(row * ld + bj * 128 + cl) * 2u) = pack8(acc[ai][bj][m][0] * s, acc[ai][bj][m][1] * s);
                }
        } else {
            bf16_t* base = glu + (pn - 3) * 128;
#pragma unroll
            for (int ai = 0; ai < 2; ++ai)
#pragma unroll
                for (int m = 0; m < 4; ++m) {
                    const int row = row0 + ai * 128 + m * 16; const float rs = rs8[ai * 4 + m];
                    f32x4 o[2];
#pragma unroll
                    for (int n = 0; n < 2; ++n) { const f32x4 av = acc[ai][0][m][n] * rs, bv = acc[ai][1][m][n] * rs;
#pragma unroll
                        for (int j = 0; j < 4; ++j) o[n][j] = av[j] * sigmoid_f(bv[j]); }
                    *at<u32x4>(base, (unsigned)(row * 512 + cl) * 2u) = pack8(o[0], o[1]);
                }
        }
    }
};

struct EpiOddIn {
    bf16_t* gate; bf16_t* urec; const float* ssq;
    __device__ __forceinline__ void operator()(const Acc& acc, const pg8::Unit& u, int wr, int wc, int fr, int fq, LAS float* rcache, int& cached_pm) const {
        const int row0 = u.pm * 256 + wr * 64 + fr, cl = wc * 32 + 8 * fq, pn = u.pn;
        float rs8[8]; get_rstd8(ssq, u.pm, row0, fr, fq, rcache, cached_pm, rs8);
        if (pn < 4) {
            bf16_t* base = gate + pn * 256;
#pragma unroll
            for (int ai = 0; ai < 2; ++ai)
#pragma unroll
                for (int m = 0; m < 4; ++m) {
                    const int row = row0 + ai * 128 + m * 16; const float rs = rs8[ai * 4 + m];
#pragma unroll
                    for (int bj = 0; bj < 2; ++bj) {
                        f32x4 v0 = acc[ai][bj][m][0] * rs, v1 = acc[ai][bj][m][1] * rs;
#pragma unroll
                        for (int j = 0; j < 4; ++j) { v0[j] = gelu_tanh_f(v0[j]); v1[j] = gelu_tanh_f(v1[j]); }
                        *at<u32x4>(base, (unsigned)(row * DM + bj * 128 + cl) * 2u) = pack8(v0, v1);
                    }
                }
        } else {
            bf16_t* base = urec + (pn - 4) * 256;
#pragma unroll
            for (int ai = 0; ai < 2; ++ai)
#pragma unroll
                for (int m = 0; m < 4; ++m) {
                    const int row = row0 + ai * 128 + m * 16; const float rs = rs8[ai * 4 + m];
#pragma unroll
                    for (int bj = 0; bj < 2; ++bj) *at<u32x4>(base, (unsigned)(row * DM + bj * 128 + cl) * 2u) = pack8(acc[ai][bj][m][0] * rs, acc[ai][bj][m][1] * rs);
                }
        }
    }
};

struct EpiLru {
    const bf16_t* xc; bf16_t* om; bf16_t* bx; const float* ga_b; const float* gx_b; const float* lsl;
    __device__ __forceinline__ void operator()(const Acc& acc, const pg8::Unit& u, int wr, int wc, int fr, int fq, LAS float* rcache, int& cached_pm) const {
        const int row0 = u.pm * 256 + wr * 64 + fr, col0 = u.pn * 128 + wc * 32 + 8 * fq;
        f32x4 ba[2], bb[2], ls[2]; u32x4 xw[8];
#pragma unroll
        for (int n = 0; n < 2; ++n) { ba[n] = *at<const f32x4>(ga_b, (unsigned)(col0 + 4 * n) * 4u); bb[n] = *at<const f32x4>(gx_b, (unsigned)(col0 + 4 * n) * 4u); ls[n] = *at<const f32x4>(lsl, (unsigned)(col0 + 4 * n) * 4u); }
#pragma unroll
        for (int i = 0; i < 8; ++i) xw[i] = *at<const u32x4>(xc, (unsigned)((row0 + (i >> 2) * 128 + (i & 3) * 16) * DM + col0) * 2u);
#pragma unroll
        for (int ai = 0; ai < 2; ++ai)
#pragma unroll
            for (int m = 0; m < 4; ++m) {
                const int row = row0 + ai * 128 + m * 16; const unsigned off = (unsigned)(row * DM + col0);
                f32x4 ov[2], bv[2];
#pragma unroll
                for (int n = 0; n < 2; ++n)
#pragma unroll
                    for (int j = 0; j < 4; ++j) {
                        const unsigned w = xw[ai * 4 + m][n * 2 + (j >> 1)]; const float xv = (j & 1) ? bf_hi(w) : bf_lo(w);
                        const float r = sigmoid_f(acc[ai][0][m][n][j] + ba[n][j]), ig = sigmoid_f(acc[ai][1][m][n][j] + bb[n][j]);
                        const float aa = __expf(r * (8.0f * ls[n][j]));
                        ov[n][j] = 1.0f - aa; bv[n][j] = __builtin_amdgcn_sqrtf(fmaxf(1.0f - aa * aa, 0.f)) * (ig * xv);
                    }
                *at<u32x4>(om, off * 2u) = pack8(ov[0], ov[1]);
                *at<u32x4>(bx, off * 2u) = pack8(bv[0], bv[1]);
            }
    }
};

__device__ __forceinline__ void transpose_tile(const float* W, int ldw, const float* gain, bf16_t* WT, int ldt, int k0, int n0, int drow0, LAS float* scr, int lane) {
    const int r = lane >> 4, c4 = lane & 15;
    f32x4 v[16];
#pragma unroll
    for (int i = 0; i < 16; ++i) v[i] = *(const f32x4*)(W + (size_t)(k0 + 4 * i + r) * ldw + n0 + 4 * c4);
    if (gain) {
#pragma unroll
        for (int i = 0; i < 16; ++i) v[i] = v[i] * gain[k0 + 4 * i + r];
    }
#pragma unroll
    for (int i = 0; i < 16; ++i)
#pragma unroll
        for (int j = 0; j < 4; ++j) scr[(4 * i + r) * 65 + 4 * c4 + j] = v[i][j];
    asm volatile("s_waitcnt lgkmcnt(0)" ::: "memory");
    const int c = lane & 7;
#pragma unroll
    for (int jj = 0; jj < 8; ++jj) { const int n = (lane >> 3) + 8 * jj; const LAS float* sp = scr + (8 * c) * 65 + n;
        u32x4 o; o.x = cvt_pk_w(sp[0 * 65], sp[1 * 65]); o.y = cvt_pk_w(sp[2 * 65], sp[3 * 65]); o.z = cvt_pk_w(sp[4 * 65], sp[5 * 65]); o.w = cvt_pk_w(sp[6 * 65], sp[7 * 65]);
        *(u32x4*)(WT + (size_t)(drow0 + n) * ldt + k0 + 8 * c) = o; }
    asm volatile("s_waitcnt lgkmcnt(0)" ::: "memory");
}

struct Args { const float* in[28]; float* out; unsigned char* ws; };

__device__ __forceinline__ void prologue(const Args& A, LAS unsigned char* lds, int tid, int G) {
    const int lane = tid & 63, wave = tid >> 6;
    unsigned char* ws = A.ws;
    LAS float* scr = (LAS float*)(lds + wave * 16640);
    const int gw = blockIdx.x * 8 + wave, NGW = G * 8;
    constexpr int NI_FFN = 8 * 2112, NI_EVEN = 2 * 704, NI_ODD = 2 * 768;
    for (int it = gw; it < NI_FFN + NI_EVEN + NI_ODD; it += NGW) {
        if (it < NI_FFN) {
            const int f = it / 2112, r = it % 2112, layer = f >> 1, which = f & 1, mat = r / 704, r2 = r % 704;
            bf16_t* wgu = (bf16_t*)(ws + WS_FFN + (size_t)f * FFN_STRIDE); bf16_t* wd = (bf16_t*)(ws + WS_FFN + (size_t)f * FFN_STRIDE + WGU_BYTES);
            if (mat < 2) {
                const float* W = A.in[(which ? 7 : 2) + mat] + (size_t)layer * DM * DFF; const float* gain = A.in[which ? 6 : 1] + layer * DM;
                const int kb = r2 / 44, nb = r2 % 44, n0 = nb * 64, drow0 = (n0 >> 7) * 256 + mat * 128 + (n0 & 127);
                transpose_tile(W, DFF, gain, wgu, DM, kb * 64, n0, drow0, scr, lane);
            } else {
                const float* W = A.in[which ? 9 : 4] + (size_t)layer * DFF * DM;
                const int kb = r2 / 16, nb = r2 % 16;
                transpose_tile(W, DM, nullptr, wd, DFF, kb * 64, nb * 64, nb * 64, scr, lane);
            }
        } else if (it < NI_FFN + NI_EVEN) {
            const int q = it - NI_FFN, e = q / 704, r = q % 704;
            bf16_t* win = (bf16_t*)(ws + WS_EVEN + (size_t)e * EVEN_STRIDE); bf16_t* wout = (bf16_t*)(ws + WS_EVEN + (size_t)e * EVEN_STRIDE + EVEN_WIN_BYTES);
            if (r < 448) {
                const int kb = r / 28, nb = r % 28, n0 = nb * 64; int drow0;
                if (n0 < 768) drow0 = n0; else if (n0 < 1280) { const int c = n0 - 768; drow0 = 768 + (c >> 7) * 256 + (c & 127); } else { const int c = n0 - 1280; drow0 = 768 + (c >> 7) * 256 + 128 + (c & 127); }
                transpose_tile(A.in[11] + (size_t)e * DM * EVEN_IN, EVEN_IN, A.in[5] + (2 * e) * DM, win, DM, kb * 64, n0, drow0, scr, lane);
            } else {
                const int r2 = r - 448, kb = r2 / 16, nb = r2 % 16;
                transpose_tile(A.in[17] + (size_t)e * DM * DM, DM, nullptr, wout, DM, kb * 64, nb * 64, nb * 64, scr, lane);
            }
        } else {
            const int q = it - NI_FFN - NI_EVEN, o = q / 768, r = q % 768;
            bf16_t* win = (bf16_t*)(ws + WS_ODD + (size_t)o * ODD_STRIDE); bf16_t* wout = (bf16_t*)(ws + WS_ODD + (size_t)o * ODD_STRIDE + 4 * MiB);
            if (r < 512) {
                const int kb = r / 32, nb = r % 32;
                transpose_tile(A.in[18] + (size_t)o * DM * 2048, 2048, A.in[5] + (2 * o + 1) * DM, win, DM, kb * 64, nb * 64, nb * 64, scr, lane);
            } else {
                const int r2 = r - 512, kb = r2 / 16, nb = r2 % 16;
                transpose_tile(A.in[26] + (size_t)o * DM * DM, DM, nullptr, wout, DM, kb * 64, nb * 64, nb * 64, scr, lane);
            }
        }
    }
    {
        const int gt = blockIdx.x * 512 + tid, NT = G * 512;
        for (int idx = gt; idx < 2 * 8 * 256 * 16; idx += NT) {
            const int k8 = idx & 15, row = (idx >> 4) & 255, h = (idx >> 12) & 7, o = idx >> 15;
            const int i0 = k8 * 8;
            const float* src = A.in[row < 128 ? 21 : 23] + ((size_t)(o * 8 + h) * 128 + i0) * 128 + (row & 127);
            u32x4 w; w.x = cvt_pk_w(src[0], src[128]); w.y = cvt_pk_w(src[256], src[384]); w.z = cvt_pk_w(src[512], src[640]); w.w = cvt_pk_w(src[768], src[896]);
            bf16_t* dst = (bf16_t*)(ws + WS_ODD + (size_t)o * ODD_STRIDE + 6 * MiB) + ((size_t)h * 256 + row) * 128 + i0;
            *(u32x4*)dst = w;
        }
        float* tab = (float*)(ws + WS_TAB);
        for (int idx = gt; idx < 2048 + 1024; idx += NT) {
            if (idx < 2048) { const float lam = A.in[25][idx]; tab[idx] = -log1pf(expf(-lam)); }
            else { const int j = idx - 2048, hd = j >> 7, dist = j & 127; int bucket;
                if (dist < 16) bucket = dist; else { bucket = 16 + (int)(logf((float)dist / 16.0f) / 2.0794415416798357f * 16.0f); if (bucket > 31) bucket = 31; }
                tab[idx] = A.in[10][bucket * 8 + hd]; }
        }
    }
    {
        const float* x = A.in[0]; bf16_t* hb = (bf16_t*)(ws + WS_HB); float* ssq = (float*)(ws + WS_SSQ);
        for (int row = gw; row < MTOK; row += 2 * NGW) {
            const int row1 = row + NGW; const bool has1 = row1 < MTOK; const int r1 = has1 ? row1 : row;
            const f32x4* xr0 = (const f32x4*)(x + (size_t)row * DM) + lane * 2; const f32x4* xr1 = (const f32x4*)(x + (size_t)r1 * DM) + lane * 2;
            f32x4 a0[2], b0[2], a1[2], b1[2]; float s0 = 0.f, s1 = 0.f;
#pragma unroll
            for (int j = 0; j < 2; ++j) { a0[j] = xr0[128 * j]; b0[j] = xr0[128 * j + 1]; a1[j] = xr1[128 * j]; b1[j] = xr1[128 * j + 1]; }
#pragma unroll
            for (int j = 0; j < 2; ++j) {
                s0 += (a0[j][0] * a0[j][0] + a0[j][1] * a0[j][1]) + (a0[j][2] * a0[j][2] + a0[j][3] * a0[j][3]) + (b0[j][0] * b0[j][0] + b0[j][1] * b0[j][1]) + (b0[j][2] * b0[j][2] + b0[j][3] * b0[j][3]);
                s1 += (a1[j][0] * a1[j][0] + a1[j][1] * a1[j][1]) + (a1[j][2] * a1[j][2] + a1[j][3] * a1[j][3]) + (b1[j][0] * b1[j][0] + b1[j][1] * b1[j][1]) + (b1[j][2] * b1[j][2] + b1[j][3] * b1[j][3]);
                *(u32x4*)(hb + (size_t)row * DM + j * 512 + lane * 8) = pack8_rne(a0[j], b0[j]);
                if (has1) *(u32x4*)(hb + (size_t)row1 * DM + j * 512 + lane * 8) = pack8_rne(a1[j], b1[j]); }
            { s0 = wave_sum(s0); s1 = wave_sum(s1); }
            if (lane < 4) { *(f32x4*)(ssq + (size_t)row * 16 + lane * 4) = (f32x4){lane == 0 ? s0 : 0.f, 0.f, 0.f, 0.f};
                if (has1) *(f32x4*)(ssq + (size_t)row1 * 16 + lane * 4) = (f32x4){lane == 0 ? s1 : 0.f, 0.f, 0.f, 0.f}; }
        }
    }
}

__device__ __forceinline__ int crow(int r, int hi) { return (r & 3) + 8 * (r >> 2) + 4 * hi; }

__device__ __forceinline__ void attn_phase(LAS unsigned char* lds, const bf16_t* q, const bf16_t* kv, bf16_t* cat, const float* btab, const float* sinks, int tid, int G) {
    asm volatile("" : "+v"(tid));
    const int lane = tid & 63, wave = tid >> 6, l31 = lane & 31, hi = lane >> 5;
    LAS bf16_t* Ks = (LAS bf16_t*)lds;
    LAS bf16_t* Vt = (LAS bf16_t*)(lds + 36864);
    LAS float* btx = (LAS float*)(lds + 36864 + 33792);
    const int g = wave >> 1;
    const float LOG2E = 1.4426950408889634f;
    for (int i = tid; i < 8 * 192; i += 512) { const int hh = i / 192, x = i % 192, dist = x - 32; btx[i] = (dist >= 0 && dist < 128) ? btab[hh * 128 + dist] * LOG2E : -1e30f; }
    for (int unit = blockIdx.x; unit < 1024; unit += G) {
        const int nbk = unit >> 1, n = nbk & 15, tok0 = nbk * 128, hku = unit & 1;
        const float sink = sinks[hku * 4 + g] * LOG2E;
        const LAS float* bp = btx + (hku * 4 + g) * 192 + 32 + (128 + l31 - 4 * hi) - 155;
        __syncthreads();
#pragma unroll
        for (int i = 0; i < 4; ++i) {
            const int c = tid + 512 * i, sj = c >> 3, ch = c & 7;
            u32x4 kw = (u32x4){0u, 0u, 0u, 0u};
            if (n > 0 || sj >= 128) kw = *at<const u32x4>(kv, (unsigned)((tok0 - 128 + sj) * 256 + hku * 64 + ch * 8) * 2u);
            *(LAS u32x4*)(Ks + sj * 72 + ch * 8) = kw;
        }
#pragma unroll
        for (int i = 0; i < 4; ++i) {
            const int c = tid + 512 * i, sj = c & 255, ch = c >> 8;
            u32x4 vw = (u32x4){0u, 0u, 0u, 0u};
            if (n > 0 || sj >= 128) vw = *at<const u32x4>(kv, (unsigned)((tok0 - 128 + sj) * 256 + 128 + hku * 64 + ch * 8) * 2u);
#pragma unroll
            for (int e = 0; e < 8; ++e) Vt[(ch * 8 + e) * 264 + sj] = (bf16_t)(vw[e >> 1] >> (16 * (e & 1)));
        }
        __syncthreads();
#pragma unroll 1
        for (int pair = 0; pair < 2; ++pair) {
            const int t = (wave & 1) * 2 + pair, qi = 32 * t + l31; const unsigned qrow = (unsigned)(tok0 + qi);
            bf16x8 qf[4];
#pragma unroll
            for (int st = 0; st < 4; ++st) qf[st] = *at<const bf16x8>(q, (unsigned)(qrow * 512 + (hku * 4 + g) * 64 + st * 16 + hi * 8) * 2u);
            f32x16 s[5];
#pragma unroll
            for (int k5 = 0; k5 < 5; ++k5) {
                s[k5] = (f32x16){0.f, 0.f, 0.f, 0.f, 0.f, 0.f, 0.f, 0.f, 0.f, 0.f, 0.f, 0.f, 0.f, 0.f, 0.f, 0.f};
#pragma unroll
                for (int st = 0; st < 4; ++st) { const bf16x8 kf = *(const LAS bf16x8*)(Ks + (32 * (t + k5) + l31) * 72 + st * 16 + hi * 8);
                    s[k5] = MFMA32(kf, qf[st], s[k5]); }
            }
            float mx = sink;
#pragma unroll
            for (int k5 = 0; k5 < 5; ++k5) {
                const bool dead = (n == 0) && (t + k5 < 4);
#pragma unroll
                for (int r = 0; r < 16; ++r) {
                    float v = s[k5][r] + bp[155 - (32 * k5 + crow(r, 0))];
                    v = dead ? -1e30f : v;
                    s[k5][r] = v; mx = fmaxf(mx, v);
                }
            }
            mx = max_x32(mx);
            float sum = 0.f;
#pragma unroll
            for (int k5 = 0; k5 < 5; ++k5)
#pragma unroll
                for (int r = 0; r < 16; ++r) { const float p = __builtin_amdgcn_exp2f(s[k5][r] - mx); s[k5][r] = p; sum += p; }
            sum = sum_x32(sum); sum += __builtin_amdgcn_exp2f(sink - mx);
            const float inv = 1.0f / sum;
            f32x16 o[2];
            o[0] = (f32x16){0.f, 0.f, 0.f, 0.f, 0.f, 0.f, 0.f, 0.f, 0.f, 0.f, 0.f, 0.f, 0.f, 0.f, 0.f, 0.f}; o[1] = o[0];
#pragma unroll
            for (int k5 = 0; k5 < 5; ++k5)
#pragma unroll
                for (int s2 = 0; s2 < 2; ++s2) {
                    u32x4 pw; pw.x = cvt_pk_rtz(s[k5][8 * s2 + 0], s[k5][8 * s2 + 1]); pw.y = cvt_pk_rtz(s[k5][8 * s2 + 2], s[k5][8 * s2 + 3]);
                    pw.z = cvt_pk_rtz(s[k5][8 * s2 + 4], s[k5][8 * s2 + 5]); pw.w = cvt_pk_rtz(s[k5][8 * s2 + 6], s[k5][8 * s2 + 7]);
                    const bf16x8 pb = __builtin_bit_cast(bf16x8, pw);
#pragma unroll
                    for (int dt = 0; dt < 2; ++dt) {
                        const LAS bf16_t* vp = Vt + (dt * 32 + l31) * 264 + 32 * (t + k5) + 16 * s2 + 4 * hi;
                        const u32x2 lo = *(const LAS u32x2*)vp, hh = *(const LAS u32x2*)(vp + 8);
                        const u32x4 vw = (u32x4){lo.x, lo.y, hh.x, hh.y};
                        o[dt] = MFMA32(__builtin_bit_cast(bf16x8, vw), pb, o[dt]);
                    }
                }
#pragma unroll
            for (int dt = 0; dt < 2; ++dt)
#pragma unroll
                for (int j = 0; j < 4; ++j) {
                    u32x2 w; w.x = cvt_pk_rtz(o[dt][4 * j] * inv, o[dt][4 * j + 1] * inv); w.y = cvt_pk_rtz(o[dt][4 * j + 2] * inv, o[dt][4 * j + 3] * inv);
                    *at<u32x2>(cat, (qrow * DM + (hku * 4 + g) * 64 + 32 * dt + 8 * j + 4 * hi) * 2u) = w;
                }
        }
    }
    __syncthreads();
}

typedef float f32x2 __attribute__((ext_vector_type(2)));
__device__ __forceinline__ void conv_phase(LAS unsigned char* lds, const bf16_t* glu, bf16_t* cat, const float* cw, const float* cb, const float* lg, const float* lb, int tid, int G) {
    asm volatile("" : "+v"(tid));
    const int lane = tid & 63, wave = tid >> 6, c = tid;
    LAS bf16_t* xin = (LAS bf16_t*)lds;
    LAS float* yb = (LAS float*)(lds + 63488);
    f32x2 E[16], O[16];
#pragma unroll
    for (int i = 0; i < 16; ++i) {
        const float we = (2 * i <= 30) ? cw[(2 * i) * 512 + c] : 0.f, wm = (2 * i - 1 >= 0) ? cw[(2 * i - 1) * 512 + c] : 0.f, wo = (2 * i + 1 <= 30) ? cw[(2 * i + 1) * 512 + c] : 0.f;
        E[i] = (f32x2){we, wm}; O[i] = (f32x2){wo, we};
    }
    const float bias = cb[c];
    const f32x4 g0 = *(const f32x4*)(lg + lane * 8), g1 = *(const f32x4*)(lg + lane * 8 + 4), b0 = *(const f32x4*)(lb + lane * 8), b1 = *(const f32x4*)(lb + lane * 8 + 4);
    u32x4 pf[8];
#define CONV_PREFETCH(tile_) do { const int t0_ = (tile_) * 32; const bool first_ = (t0_ & (SEQ - 1)) == 0; \
        _Pragma("unroll") for (int i = 0; i < 8; ++i) { const int ch = tid + 512 * i, r = ch >> 6, cc = ch & 63; pf[i] = (u32x4){0u, 0u, 0u, 0u}; \
            if (ch < 62 * 64 && !(first_ && r < 30)) pf[i] = *at<const u32x4>(glu, (unsigned)((t0_ - 30 + r) * 512 + cc * 8) * 2u); } } while (0)
    int tile = blockIdx.x;
    if (tile < MTOK / 32) CONV_PREFETCH(tile);
    for (; tile < MTOK / 32; tile += G) {
        const int t0 = tile * 32;
        __syncthreads();
#pragma unroll
        for (int i = 0; i < 8; ++i) { const int ch = tid + 512 * i, r = ch >> 6, cc = ch & 63; if (ch < 62 * 64) *(LAS u32x4*)(xin + r * 512 + cc * 8) = pf[i]; }
        __syncthreads();
        if (tile + G < MTOK / 32) CONV_PREFETCH(tile + G);
        f32x2 y2[16];
#pragma unroll
        for (int p = 0; p < 16; ++p) y2[p] = (f32x2){bias, bias};
#pragma unroll
        for (int r = 0; r < 62; ++r) { const float xv = bf2f(xin[r * 512 + c]); const f32x2 xv2 = (f32x2){xv, xv};
#pragma unroll
            for (int p = 0; p < 16; ++p) { const int k = r - 2 * p; if (k >= 0 && k <= 31) y2[p] = ((k & 1) ? O[(k - 1) / 2] : E[k / 2]) * xv2 + y2[p]; } }
#pragma unroll
        for (int p = 0; p < 16; ++p) { yb[(2 * p) * 512 + c] = y2[p].x; yb[(2 * p + 1) * 512 + c] = y2[p].y; }
        __syncthreads();
#pragma unroll
        for (int i = 0; i < 4; ++i) { const int tt = wave * 4 + i;
            f32x4 a = *(const LAS f32x4*)(yb + tt * 512 + lane * 8), b = *(const LAS f32x4*)(yb + tt * 512 + lane * 8 + 4);
            const float mean = wave_sum((a[0] + a[1]) + (a[2] + a[3]) + (b[0] + b[1]) + (b[2] + b[3])) * (1.0f / 512.0f);
            a = a - mean; b = b - mean;
            const float var = wave_sum((a[0] * a[0] + a[1] * a[1]) + (a[2] * a[2] + a[3] * a[3]) + (b[0] * b[0] + b[1] * b[1]) + (b[2] * b[2] + b[3] * b[3])) * (1.0f / 512.0f);
            const float rstd = rsqrtf(var + LN_EPS);
            a = a * rstd * g0 + b0; b = b * rstd * g1 + b1;
#pragma unroll
            for (int j = 0; j < 4; ++j) { a[j] = silu_f(a[j]); b[j] = silu_f(b[j]); }
            *(u32x4*)(cat + (size_t)(t0 + tt) * DM + 512 + lane * 8) = pack8(a, b); }
    }
#undef CONV_PREFETCH
    __syncthreads();
}

__device__ __forceinline__ void conv4_phase(const bf16_t* urec, bf16_t* xc, const float* cw, const float* cb, int tid, int G) {
    asm volatile("" : "+v"(tid));
    const int gt = blockIdx.x * 512 + tid, NT = G * 512;
    for (int it = gt; it < (MTOK / 16) * 128; it += NT) {
        const int cgp = it & 127, run = it >> 7, t0 = run * 16, c0 = cgp * 8;
        float w[4][8], b[8], x0[8], x1[8], x2[8];
#pragma unroll
        for (int k = 0; k < 4; ++k) { const f32x4 a = *(const f32x4*)(cw + k * DM + c0), bq = *(const f32x4*)(cw + k * DM + c0 + 4);
#pragma unroll
            for (int j = 0; j < 4; ++j) { w[k][j] = a[j]; w[k][4 + j] = bq[j]; } }
        { const f32x4 a = *(const f32x4*)(cb + c0), bq = *(const f32x4*)(cb + c0 + 4);
#pragma unroll
            for (int j = 0; j < 4; ++j) { b[j] = a[j]; b[4 + j] = bq[j]; } }
#pragma unroll
        for (int j = 0; j < 8; ++j) { x0[j] = 0.f; x1[j] = 0.f; x2[j] = 0.f; }
        if ((t0 & (SEQ - 1)) != 0) {
            const u32x4 a = *(const u32x4*)(urec + (size_t)(t0 - 3) * DM + c0), bq = *(const u32x4*)(urec + (size_t)(t0 - 2) * DM + c0), cq = *(const u32x4*)(urec + (size_t)(t0 - 1) * DM + c0);
#pragma unroll
            for (int j = 0; j < 4; ++j) { x0[2 * j] = bf_lo(a[j]); x0[2 * j + 1] = bf_hi(a[j]); x1[2 * j] = bf_lo(bq[j]); x1[2 * j + 1] = bf_hi(bq[j]); x2[2 * j] = bf_lo(cq[j]); x2[2 * j + 1] = bf_hi(cq[j]); }
        }
#pragma unroll 8
        for (int tt = 0; tt < 16; ++tt) {
            const u32x4 a = *(const u32x4*)(urec + (size_t)(t0 + tt) * DM + c0);
            float x3[8], y[8];
#pragma unroll
            for (int j = 0; j < 4; ++j) { x3[2 * j] = bf_lo(a[j]); x3[2 * j + 1] = bf_hi(a[j]); }
#pragma unroll
            for (int j = 0; j < 8; ++j) y[j] = b[j] + w[0][j] * x0[j] + w[1][j] * x1[j] + w[2][j] * x2[j] + w[3][j] * x3[j];
            u32x4 o; o.x = cvt_pk_rtz(y[0], y[1]); o.y = cvt_pk_rtz(y[2], y[3]); o.z = cvt_pk_rtz(y[4], y[5]); o.w = cvt_pk_rtz(y[6], y[7]);
            *(u32x4*)(xc + (size_t)(t0 + tt) * DM + c0) = o;
#pragma unroll
            for (int j = 0; j < 8; ++j) { x0[j] = x1[j]; x1[j] = x2[j]; x2[j] = x3[j]; }
        }
    }
}

__device__ __forceinline__ void scan_phase(LAS unsigned char* lds, const bf16_t* om, const bf16_t* bx, const bf16_t* gate, bf16_t* y, int tid, int G) {
    asm volatile("" : "+v"(tid));
    LAS float* PS = (LAS float*)lds;
    const int cq = tid & 15, chunk = tid >> 4;
    for (int item = blockIdx.x; item < 512; item += G) {
        const int b = item >> 4, cgp = item & 15;
        const unsigned base = (unsigned)(((b * SEQ + chunk * 64) * DM + cgp * 64 + cq * 4) * 2);
        float P[4] = {1.f, 1.f, 1.f, 1.f}, S[4] = {0.f, 0.f, 0.f, 0.f};
        for (int t = 0; t < 64; t += 8) {
            u32x2 ow[8], bw[8];
#pragma unroll
            for (int i = 0; i < 8; ++i) { ow[i] = *at<const u32x2>(om, base + (unsigned)(t + i) * (DM * 2)); bw[i] = *at<const u32x2>(bx, base + (unsigned)(t + i) * (DM * 2)); }
#pragma unroll
            for (int i = 0; i < 8; ++i) {
                const float a0 = 1.0f - bf_lo(ow[i].x), a1 = 1.0f - bf_hi(ow[i].x), a2 = 1.0f - bf_lo(ow[i].y), a3 = 1.0f - bf_hi(ow[i].y);
                P[0] *= a0; P[1] *= a1; P[2] *= a2; P[3] *= a3;
                S[0] = a0 * S[0] + bf_lo(bw[i].x); S[1] = a1 * S[1] + bf_hi(bw[i].x); S[2] = a2 * S[2] + bf_lo(bw[i].y); S[3] = a3 * S[3] + bf_hi(bw[i].y);
            }
        }
        __syncthreads();
#pragma unroll
        for (int j = 0; j < 4; ++j) { PS[(chunk * 64 + cq * 4 + j) * 2] = P[j]; PS[(chunk * 64 + cq * 4 + j) * 2 + 1] = S[j]; }
        __syncthreads();
        float h[4] = {0.f, 0.f, 0.f, 0.f};
        for (int c = 0; c < chunk; ++c) {
#pragma unroll
            for (int j = 0; j < 4; ++j) h[j] = PS[(c * 64 + cq * 4 + j) * 2] * h[j] + PS[(c * 64 + cq * 4 + j) * 2 + 1];
        }
        for (int t = 0; t < 64; t += 8) {
            u32x2 ow[8], bw[8], gw[8];
#pragma unroll
            for (int i = 0; i < 8; ++i) { ow[i] = *at<const u32x2>(om, base + (unsigned)(t + i) * (DM * 2)); bw[i] = *at<const u32x2>(bx, base + (unsigned)(t + i) * (DM * 2)); gw[i] = *at<const u32x2>(gate, base + (unsigned)(t + i) * (DM * 2)); }
#pragma unroll
            for (int i = 0; i < 8; ++i) {
                h[0] = (1.0f - bf_lo(ow[i].x)) * h[0] + bf_lo(bw[i].x); h[1] = (1.0f - bf_hi(ow[i].x)) * h[1] + bf_hi(bw[i].x);
                h[2] = (1.0f - bf_lo(ow[i].y)) * h[2] + bf_lo(bw[i].y); h[3] = (1.0f - bf_hi(ow[i].y)) * h[3] + bf_hi(bw[i].y);
                u32x2 o; o.x = cvt_pk_rtz(bf_lo(gw[i].x) * h[0], bf_hi(gw[i].x) * h[1]); o.y = cvt_pk_rtz(bf_lo(gw[i].y) * h[2], bf_hi(gw[i].y) * h[3]);
                *at<u32x2>(y, base + (unsigned)(t + i) * (DM * 2)) = o;
            }
        }
    }
    __syncthreads();
}

__device__ __forceinline__ void final_norm(const bf16_t* hb, float* out, const float* gain, int tid, int G) {
    asm volatile("" : "+v"(tid));
    const int lane = tid & 63, wave = tid >> 6, gw = blockIdx.x * 8 + wave, NGW = G * 8;
    f32x4 gv[4];
#pragma unroll
    for (int j = 0; j < 4; ++j) gv[j] = *(const f32x4*)(gain + j * 256 + lane * 4);
    for (int row = gw; row < MTOK; row += 2 * NGW) {
        const int row1 = row + NGW; const bool has1 = row1 < MTOK;
        const u32x2* hr0 = (const u32x2*)(hb + (size_t)row * DM) + lane; const u32x2* hr1 = (const u32x2*)(hb + (size_t)(has1 ? row1 : row) * DM) + lane;
        f32x4 v0[4], v1[4]; float s0 = 0.f, s1 = 0.f;
#pragma unroll
        for (int j = 0; j < 4; ++j) { const u32x2 w0 = hr0[64 * j], w1 = hr1[64 * j];
            v0[j] = (f32x4){bf_lo(w0.x), bf_hi(w0.x), bf_lo(w0.y), bf_hi(w0.y)}; v1[j] = (f32x4){bf_lo(w1.x), bf_hi(w1.x), bf_lo(w1.y), bf_hi(w1.y)};
            s0 += (v0[j][0] * v0[j][0] + v0[j][1] * v0[j][1]) + (v0[j][2] * v0[j][2] + v0[j][3] * v0[j][3]); s1 += (v1[j][0] * v1[j][0] + v1[j][1] * v1[j][1]) + (v1[j][2] * v1[j][2] + v1[j][3] * v1[j][3]); }
        { s0 = wave_sum(s0); s1 = wave_sum(s1); }
        const float rs0 = rsqrtf(s0 * (1.0f / 1024.0f) + RMS_EPS), rs1 = rsqrtf(s1 * (1.0f / 1024.0f) + RMS_EPS);
        f32x4* o0 = (f32x4*)(out + (size_t)row * DM) + lane;
#pragma unroll
        for (int j = 0; j < 4; ++j) o0[64 * j] = v0[j] * rs0 * gv[j];
        if (has1) { f32x4* o1 = (f32x4*)(out + (size_t)row1 * DM) + lane;
#pragma unroll
            for (int j = 0; j < 4; ++j) o1[64 * j] = v1[j] * rs1 * gv[j]; }
    }
}

#define XB_TMO      128
#define XB_XCNT(j)  (256  + 64 * (j))
#define XB_XSUB(j)  (1280 + 64 * (j))
#define XB_XGEN(j)  (2304 + 64 * (j))
#define XB_TOP      3328
#define XB_TOPGEN   3392
#define XCD_BAR_WORDS 3456
#define XB_SPIN_CAP (1u << 18)
__device__ __forceinline__ unsigned xb_ld(unsigned* p)              { return __hip_atomic_load(p, __ATOMIC_RELAXED, __HIP_MEMORY_SCOPE_AGENT); }
__device__ __forceinline__ unsigned xb_add(unsigned* p, unsigned v) { return __hip_atomic_fetch_add(p, v, __ATOMIC_RELAXED, __HIP_MEMORY_SCOPE_AGENT); }
__device__ __forceinline__ unsigned xb_xcc_id() { return (unsigned)__builtin_amdgcn_s_getreg((3 << 11) | 20) & 0xFu; }
#define XB_SPIN(cond, bar) do { unsigned _sp = 0; while (cond) { __builtin_amdgcn_s_sleep(1); \
    if ((++_sp & 255u) == 0u) { if (xb_ld(&(bar)[XB_TMO])) break; if (_sp > XB_SPIN_CAP) { atomicAdd(&(bar)[XB_TMO], 1u); break; } } } } while (0)
struct XcdBarrier { unsigned* bar; unsigned x; volatile LAS unsigned* st; };
__device__ __forceinline__ XcdBarrier xcd_barrier_post(unsigned* bar, volatile LAS unsigned* st) {
    XcdBarrier b; b.bar = bar; b.x = xb_xcc_id(); b.st = st;
    if (threadIdx.x == 0) (void)xb_add(&bar[XB_XCNT(b.x)], 1u);
    return b;
}
__device__ __forceinline__ void xcd_barrier_complete(unsigned* bar, unsigned x, unsigned& nloc, unsigned& nx) {
    const unsigned G = gridDim.x * gridDim.y * gridDim.z;
    unsigned sum, cnt, mine, sp = 0u;
    for (;;) {
        sum = 0u; cnt = 0u; mine = 0u;
#pragma unroll
        for (unsigned j = 0; j < 16; ++j) { const unsigned c = xb_ld(&bar[XB_XCNT(j)]); sum += c; cnt += (c > 0u) ? 1u : 0u; mine = (j == x) ? c : mine; }
        if (sum == G) break;
        __builtin_amdgcn_s_sleep(1);
        if ((++sp & 255u) == 0u) { if (xb_ld(&bar[XB_TMO])) break; if (sp > XB_SPIN_CAP) { atomicAdd(&bar[XB_TMO], 1u); break; } }
    }
    nloc = mine > 0u ? mine : 1u; nx = cnt > 0u ? cnt : 1u;
}
__device__ __forceinline__ void xcd_barrier(unsigned* bar, unsigned x, volatile LAS unsigned* st, bool leader_thread) {
    asm volatile("s_waitcnt vmcnt(0)" ::: "memory");
    __syncthreads();
    if (leader_thread) {
        __builtin_amdgcn_s_waitcnt(0);
        unsigned nloc = st[0], nx = st[1];
        if (nloc == 0u) { xcd_barrier_complete(bar, x, nloc, nx); st[0] = nloc; st[1] = nx; }
        const unsigned old = xb_add(&bar[XB_XSUB(x)], 1u);
        const unsigned gen = old / nloc;
        if (old + 1u == (gen + 1u) * nloc) {
            __builtin_amdgcn_fence(__ATOMIC_RELEASE, "agent");
            asm volatile("s_waitcnt vmcnt(0)" ::: "memory");
            const unsigned og = xb_add(&bar[XB_TOP], 1u);
            const unsigned tg = og / nx;
            if (og + 1u == (tg + 1u) * nx) xb_add(&bar[XB_TOPGEN], 1u);
            else XB_SPIN(xb_ld(&bar[XB_TOPGEN]) == tg, bar);
            __builtin_amdgcn_fence(__ATOMIC_ACQUIRE, "agent");
            xb_add(&bar[XB_XGEN(x)], 1u);
            asm volatile("s_waitcnt vmcnt(0)" ::: "memory");
        } else {
            XB_SPIN(xb_ld(&bar[XB_XGEN(x)]) == gen, bar);
            __builtin_amdgcn_fence(__ATOMIC_ACQUIRE, "agent");
            asm volatile("s_waitcnt vmcnt(0)" ::: "memory");
        }
    }
    __syncthreads();
}

__global__ void __launch_bounds__(512, 2) hybrid_fwd(Args A) {
    extern __shared__ __attribute__((aligned(16))) unsigned char lds_raw[];
    LAS unsigned char* lds = (LAS unsigned char*)lds_raw;
    cg::grid_group grid = cg::this_grid();
    const int G = gridDim.x;
    const int wave_s = __builtin_amdgcn_readfirstlane((int)threadIdx.x >> 6);
#define TID() (wave_s * 64 + lane_id_asm())
    GAS unsigned char* ws = (GAS unsigned char*)A.ws;
    bf16_t* hb = (bf16_t*)(ws + WS_HB); float* ssq = (float*)(ws + WS_SSQ);
    const float* tab = (const float*)(ws + WS_TAB);

    volatile LAS unsigned* bst = (volatile LAS unsigned*)(lds + LDS_BYTES - 16);
    if (threadIdx.x < 2) bst[threadIdx.x] = 0u;
    __syncthreads();
    GAS unsigned* barw = (GAS unsigned*)(ws + WS_BAR);
    const unsigned bxcc = xcd_barrier_post((unsigned*)barw, bst).x;
#define GRID_BAR() do { asm volatile("" : "+s"(barw)); xcd_barrier((unsigned*)barw, bxcc, bst, lane_id_asm() == 0 && wave_s == 0); } while (0)
    prologue(A, lds, TID(), G);
    if (A.out == nullptr) grid.sync();
    GRID_BAR();

    for (int layer = 0; layer < 4; ++layer) {
        for (int sub = 0; sub < 3; ++sub) {
            asm volatile("" : "+s"(ws));
            int z = 0; asm volatile("" : "+s"(z));
            int bid = blockIdx.x, Gv = gridDim.x; asm volatile("" : "+s"(bid), "+s"(Gv));
            pg8::Gemm gres; float scale;
            if (sub != 1) {
                const int f = layer * 2 + (sub >> 1);
                const bf16_t* wgu = (const bf16_t*)(ws + WS_FFN + (size_t)f * FFN_STRIDE); const bf16_t* wd = (const bf16_t*)(ws + WS_FFN + (size_t)f * FFN_STRIDE + WGU_BYTES);
                bf16_t* mid = (bf16_t*)(ws + WS_MID);
                { pg8::Gemm g{hb, wgu, MTOK, NGU, DM, DM, DM, 0}; pg8::StaticOrder S; S.init(MTOK, NGU, Gv, bid);
                  EpiGU E{mid, ssq}; pg8::gemm_phase<EpiGU>(lds, g, S, E, TID()); }
                GRID_BAR();
                gres = pg8::Gemm{mid, wd, MTOK, DM, DFF, DFF, DFF, 0}; scale = 0.5f;
            } else if ((layer & 1) == 0) {
                const int e = layer >> 1;
                const bf16_t* win = (const bf16_t*)(ws + WS_EVEN + (size_t)e * EVEN_STRIDE); const bf16_t* wout = (const bf16_t*)(ws + WS_EVEN + (size_t)e * EVEN_STRIDE + EVEN_WIN_BYTES);
                bf16_t* qb = (bf16_t*)(ws + WS_Q); bf16_t* kvb = (bf16_t*)(ws + WS_KV); bf16_t* glu = (bf16_t*)(ws + WS_GLU); bf16_t* cat = (bf16_t*)(ws + WS_CAT);
                { pg8::Gemm g{hb, win, MTOK, EVEN_IN, DM, DM, DM, 0}; pg8::StaticOrder S; S.init(MTOK, EVEN_IN, Gv, bid);
                  EpiEvenIn E{qb, kvb, glu, ssq}; pg8::gemm_phase<EpiEvenIn>(lds, g, S, E, TID()); }
                GRID_BAR();
                attn_phase(lds, qb, kvb, cat, tab + 2048, A.in[12 + z] + e * 8, TID(), Gv);
                conv_phase(lds, glu, cat, A.in[13 + z] + (size_t)e * 31 * 512, A.in[14 + z] + e * 512, A.in[15 + z] + e * 512, A.in[16 + z] + e * 512, TID(), Gv);
                GRID_BAR();
                gres = pg8::Gemm{cat, wout, MTOK, DM, DM, DM, DM, 0}; scale = 1.0f;
            } else {
                const int o = layer >> 1;
                const bf16_t* win = (const bf16_t*)(ws + WS_ODD + (size_t)o * ODD_STRIDE); const bf16_t* wout = (const bf16_t*)(ws + WS_ODD + (size_t)o * ODD_STRIDE + 4 * MiB);
                const bf16_t* wgate = (const bf16_t*)(ws + WS_ODD + (size_t)o * ODD_STRIDE + 6 * MiB);
                bf16_t* gate = (bf16_t*)(ws + WS_GATE); bf16_t* urec = (bf16_t*)(ws + WS_UREC); bf16_t* xc = (bf16_t*)(ws + WS_XC); bf16_t* av = (bf16_t*)(ws + WS_A);
                { pg8::Gemm g{hb, win, MTOK, 2048, DM, DM, DM, 0}; pg8::StaticOrder S; S.init(MTOK, 2048, Gv, bid);
                  EpiOddIn E{gate, urec, ssq}; pg8::gemm_phase<EpiOddIn>(lds, g, S, E, TID()); }
                GRID_BAR();
                conv4_phase(urec, xc, A.in[19 + z] + (size_t)o * 4 * DM, A.in[20 + z] + o * DM, TID(), Gv);
                GRID_BAR();
                { pg8::Gemm g{xc, wgate, MTOK, 2048, 128, DM, 128, 256}; pg8::StaticOrder S; S.init(MTOK, 2048, Gv, bid);
                  EpiLru E{xc, av, urec, A.in[22 + z] + o * DM, A.in[24 + z] + o * DM, tab + o * DM}; pg8::gemm_phase<EpiLru>(lds, g, S, E, TID()); }
                GRID_BAR();
                scan_phase(lds, av, urec, gate, xc, TID(), Gv);
                GRID_BAR();
                gres = pg8::Gemm{xc, wout, MTOK, DM, DM, DM, DM, 0}; scale = 1.0f;
            }
            { pg8::StaticOrder S; S.init(MTOK, DM, Gv, bid);
              EpiRes E{hb, ssq, scale}; pg8::gemm_phase<EpiRes>(lds, gres, S, E, TID()); }
            GRID_BAR();
        }
    }
    final_norm(hb, A.out, A.in[27], TID(), G);
}

extern "C" void kernel_launch(void* const* d_in, const int* in_sizes, int n_in, void* d_out, int out_size, void* d_ws, size_t ws_size, hipStream_t stream) {
    static int grid = 0;
    if (grid == 0) {
        if (n_in != 28 || in_sizes[0] != MTOK * DM || out_size != MTOK * DM || ws_size < WS_NEED) {
            fprintf(stderr, "kernel_launch: unexpected shapes (n_in %d, in0 %d, out %d, ws %zu; need ws >= %zu)\n", n_in, n_in > 0 ? in_sizes[0] : -1, out_size, ws_size, (size_t)WS_NEED); grid = -1; return; }
        int dev = 0, cus = 0, per_cu = 0;
        hipGetDevice(&dev); hipDeviceGetAttribute(&cus, hipDeviceAttributeMultiprocessorCount, dev);
        if (hipFuncSetAttribute((const void*)hybrid_fwd, hipFuncAttributeMaxDynamicSharedMemorySize, LDS_BYTES) != hipSuccess) { fprintf(stderr, "kernel_launch: hipFuncSetAttribute failed\n"); grid = -1; return; }
        if (hipOccupancyMaxActiveBlocksPerMultiprocessor(&per_cu, (const void*)hybrid_fwd, 512, LDS_BYTES) != hipSuccess || per_cu < 1) { fprintf(stderr, "kernel_launch: occupancy query gave %d\n", per_cu); per_cu = 1; }
        (void)hipGetLastError();
        grid = cus * per_cu;
    }
    if (grid < 0) return;
    Args a{};
    for (int i = 0; i < 28; ++i) a.in[i] = (const float*)d_in[i];
    a.out = (float*)d_out; a.ws = (unsigned char*)d_ws;
    if (hipMemsetAsync((char*)d_ws + WS_BAR, 0, XCD_BAR_WORDS * 4, stream) != hipSuccess) { fprintf(stderr, "kernel_launch: memset failed\n"); return; }
    void* args[] = {&a};
    hipError_t e = hipLaunchCooperativeKernel((const void*)hybrid_fwd, dim3(grid), dim3(512), args, LDS_BYTES, stream);
    if (e != hipSuccess) fprintf(stderr, "kernel_launch: cooperative launch failed: %s (grid %d)\n", hipGetErrorString(e), grid);
}
```

```cpp
#include <hip/hip_runtime.h>
#include <hip/hip_cooperative_groups.h>
#include <cstdio>
#include <cstdint>
namespace cg = cooperative_groups;

#define LAS __attribute__((address_space(3)))
#define GAS __attribute__((address_space(1)))
typedef unsigned short bf16_t;
typedef short bf16x8 __attribute__((ext_vector_type(8)));
typedef float f32x4 __attribute__((ext_vector_type(4)));
typedef float f32x16 __attribute__((ext_vector_type(16)));
typedef unsigned u32x4 __attribute__((ext_vector_type(4)));
typedef unsigned u32x2 __attribute__((ext_vector_type(2)));

constexpr int DM = 1024, NB = 32, SEQ = 2048, MTOK = NB * SEQ, DFF = 2816;
constexpr int NGU = 2 * DFF;
constexpr int EVEN_IN = 1792;
constexpr float RMS_EPS = 1e-6f, LN_EPS = 1e-5f;

constexpr size_t MiB = 1u << 20;
constexpr size_t WS_FFN = 0;
constexpr size_t FFN_STRIDE = 16 * MiB + MiB / 2, WGU_BYTES = 11 * MiB;
constexpr size_t WS_EVEN = 132 * MiB, EVEN_STRIDE = 5 * MiB + MiB / 2, EVEN_WIN_BYTES = 3 * MiB + MiB / 2;
constexpr size_t WS_ODD = 143 * MiB, ODD_STRIDE = 7 * MiB;
constexpr size_t WS_TAB = 157 * MiB;
constexpr size_t WS_BAR = 157 * MiB + 64 * 1024;
constexpr size_t WS_SSQ = 158 * MiB;
constexpr size_t WS_HB = 164 * MiB;
constexpr size_t WS_SCR = 292 * MiB;
constexpr size_t WS_MID = WS_SCR;
constexpr size_t WS_Q = WS_SCR, WS_KV = WS_SCR + 64 * MiB, WS_GLU = WS_SCR + 96 * MiB, WS_CAT = WS_SCR + 160 * MiB;
constexpr size_t WS_GATE = WS_SCR, WS_UREC = WS_SCR + 128 * MiB, WS_XC = WS_SCR + 256 * MiB, WS_A = WS_SCR + 384 * MiB;
constexpr size_t WS_NEED = WS_A + 256 * MiB;
static_assert(WS_NEED <= 1024 * MiB, "ws map");

constexpr int LDS_BYTES = 147456;

#ifndef USE_FP16
#define USE_FP16 0
#endif
typedef _Float16 h16x2 __attribute__((ext_vector_type(2)));
typedef _Float16 h16x8 __attribute__((ext_vector_type(8)));
#if USE_FP16
__device__ __forceinline__ unsigned cvt_pk_bf16(float lo, float hi) { h16x2 v; v.x = (_Float16)lo; v.y = (_Float16)hi; return __builtin_bit_cast(unsigned, v); }
__device__ __forceinline__ unsigned cvt_pk_rtz(float lo, float hi) { return __builtin_bit_cast(unsigned, __builtin_amdgcn_cvt_pkrtz(lo, hi)); }
__device__ __forceinline__ float bf_lo(unsigned w) { return (float)__builtin_bit_cast(h16x2, w).x; }
__device__ __forceinline__ float bf_hi(unsigned w) { return (float)__builtin_bit_cast(h16x2, w).y; }
__device__ __forceinline__ float bf2f(bf16_t b) { return (float)__builtin_bit_cast(_Float16, b); }
#define MFMA16(a, b, c) __builtin_amdgcn_mfma_f32_16x16x32_f16(__builtin_bit_cast(h16x8, a), __builtin_bit_cast(h16x8, b), c, 0, 0, 0)
#define MFMA32(a, b, c) __builtin_amdgcn_mfma_f32_32x32x16_f16(__builtin_bit_cast(h16x8, a), __builtin_bit_cast(h16x8, b), c, 0, 0, 0)
#else
typedef float cvt_f32x2_t __attribute__((ext_vector_type(2))); typedef __bf16 cvt_bf16x2_t __attribute__((ext_vector_type(2)));
__device__ __forceinline__ unsigned cvt_pk_bf16(float lo, float hi) { const cvt_f32x2_t v = {lo, hi}; return __builtin_bit_cast(unsigned, __builtin_convertvector(v, cvt_bf16x2_t)); }
__device__ __forceinline__ unsigned cvt_pk_rtz(float lo, float hi) { return cvt_pk_bf16(lo, hi); }
__device__ __forceinline__ float bf_lo(unsigned w) { return __uint_as_float(w << 16); }
__device__ __forceinline__ float bf_hi(unsigned w) { return __uint_as_float(w & 0xffff0000u); }
__device__ __forceinline__ float bf2f(bf16_t b) { return __uint_as_float((unsigned)b << 16); }
#define MFMA16(a, b, c) __builtin_amdgcn_mfma_f32_16x16x32_bf16(a, b, c, 0, 0, 0)
#define MFMA32(a, b, c) __builtin_amdgcn_mfma_f32_32x32x16_bf16(a, b, c, 0, 0, 0)
#endif
#if USE_FP16
__device__ __forceinline__ float round_bf16_f(float v) { return __uint_as_float((unsigned)__builtin_bit_cast(unsigned short, (__bf16)v) << 16); }
__device__ __forceinline__ unsigned cvt_pk_w(float lo, float hi) { return cvt_pk_bf16(round_bf16_f(lo), round_bf16_f(hi)); }
#else
__device__ __forceinline__ unsigned cvt_pk_w(float lo, float hi) { return cvt_pk_bf16(lo, hi); }
#endif
__device__ __forceinline__ float sigmoid_f(float x) { return __builtin_amdgcn_rcpf(1.0f + __expf(-x)); }
__device__ __forceinline__ float silu_f(float x) { return x * sigmoid_f(x); }
__device__ __forceinline__ float gelu_tanh_f(float x) { const float z = 0.7978845608028654f * (x + 0.044715f * x * x * x); return x * sigmoid_f(2.0f * z); }
template <int MASK> __device__ __forceinline__ float swz_xor(float v) { return __int_as_float(__builtin_amdgcn_ds_swizzle(__float_as_int(v), (MASK << 10) | 0x1F)); }
__device__ __forceinline__ float sum_x32(float v) { const auto rr = __builtin_amdgcn_permlane32_swap(__float_as_uint(v), __float_as_uint(v), false, false); return __uint_as_float(rr[0]) + __uint_as_float(rr[1]); }
__device__ __forceinline__ float max_x32(float v) { const auto rr = __builtin_amdgcn_permlane32_swap(__float_as_uint(v), __float_as_uint(v), false, false); return fmaxf(__uint_as_float(rr[0]), __uint_as_float(rr[1])); }
__device__ __forceinline__ float wave_sum(float v) {
    v += swz_xor<1>(v); v += swz_xor<2>(v); v += swz_xor<4>(v); v += swz_xor<8>(v); v += swz_xor<16>(v);
    return sum_x32(v);
}
__device__ __forceinline__ u32x4 pack8(const f32x4 a, const f32x4 b) { u32x4 w; w.x = cvt_pk_rtz(a[0], a[1]); w.y = cvt_pk_rtz(a[2], a[3]); w.z = cvt_pk_rtz(b[0], b[1]); w.w = cvt_pk_rtz(b[2], b[3]); return w; }
__device__ __forceinline__ u32x4 pack8_rne(const f32x4 a, const f32x4 b) { u32x4 w; w.x = cvt_pk_bf16(a[0], a[1]); w.y = cvt_pk_bf16(a[2], a[3]); w.z = cvt_pk_bf16(b[0], b[1]); w.w = cvt_pk_bf16(b[2], b[3]); return w; }

__device__ __forceinline__ int lane_id_asm() { int l; asm volatile("v_mbcnt_lo_u32_b32 %0, -1, 0\n\tv_mbcnt_hi_u32_b32 %0, -1, %0" : "=v"(l)); return l; }

namespace pg8 {
constexpr int BM = 256, BK = 64, HALF = 128, HTB = HALF * BK * 2, STAGE_BYTES = 8 * HTB, NXCD = 8, WGM = 8;
__host__ __device__ __forceinline__ int lds_byte(int r, int c) { const int st = (r >> 4) * 2 + (c >> 5), rr = r & 15, cc = c & 31, ob = rr * 64 + cc * 2; return st * 1024 + (ob ^ (((ob >> 9) & 1) << 5)); }
__host__ __device__ __forceinline__ void stage_rc(int b, int& R, int& C) { const int st = b / 1024, sb = b % 1024, swz = sb ^ (((sb >> 9) & 1) << 5); R = (st >> 1) * 16 + swz / 64; C = (st & 1) * 32 + (swz % 64) / 2; }
__host__ __device__ __forceinline__ int perm32(int rho) { const int n = rho >> 4, i = rho & 15; return 8 * (i >> 2) + 4 * n + (i & 3); }

struct Unit { int pm, pn; };
struct Gemm { const bf16_t* A; const bf16_t* Bt; int M, N, K, lda, ldb, acol_step; };

struct StaticOrder {
    int nM, nN, nwg, G, c;
    __host__ __device__ void init(int M, int N, int G_, int c_) { nM = M / BM; nN = N / BM; nwg = nM * nN; G = G_; c = c_; }
    __host__ __device__ bool next(int i, Unit& u) const {
        const long L = (long)i * G + c; if (L >= nwg) return false;
        int wgid = (int)L; { const int q = nwg / NXCD, r = nwg % NXCD, xcd = wgid % NXCD, off = wgid / NXCD; wgid = (xcd < r ? xcd * (q + 1) : r * (q + 1) + (xcd - r) * q) + off; }
        const int nig = WGM * nN, gid = wgid / nig, fm = gid * WGM, gsz = (nM - fm) < WGM ? (nM - fm) : WGM;
        u.pm = fm + ((wgid % nig) % gsz); u.pn = (wgid % nig) / gsz; return true;
    }
};

template <class Epi>
__device__ __forceinline__ void gemm_phase(LAS unsigned char* lds, const Gemm g, const StaticOrder& S, const Epi& E, int tid_) {
    asm volatile("" : "+v"(tid_));
    const int tid = tid_, wid = __builtin_amdgcn_readfirstlane(tid >> 6), lane = tid & 63, wr = wid >> 2, wc = wid & 3, fr = lane & 15, fq = lane >> 4;
    int nt_ = g.K / BK; asm volatile("" : "+s"(nt_));
    const int nt = nt_;
    unsigned voffA[2], voffB[2];
#pragma unroll
    for (int i = 0; i < 2; ++i) { int R, C; stage_rc(tid * 16 + i * 8192, R, C); const int Rb = (R & ~31) + perm32(R & 31);
        voffA[i] = (unsigned)(R * g.lda + C) * 2u; voffB[i] = (unsigned)(Rb * g.ldb + C) * 2u; }
    const size_t kstep = (size_t)(BK * 2);
    const size_t hsA = (size_t)HALF * g.lda * 2, hsB = (size_t)HALF * g.ldb * 2;
    const size_t tsA = 2 * hsA, tsB = 2 * hsB;
    const unsigned ldsw = (unsigned)wid * 1024u;
    const int aoff = lds_byte(wr * 64 + fr, fq * 8), boff = lds_byte(wc * 32 + fr, fq * 8);
#define PG8_SA(b, h) (((b) * 2 + (h)) * HTB)
#define PG8_SB(b, h) ((4 + (b) * 2 + (h)) * HTB)
#define PG8_STAGE(bufoff, gbase, voff) do { _Pragma("unroll") for (int _i = 0; _i < 2; ++_i) \
        __builtin_amdgcn_global_load_lds((const unsigned*)((const char*)(gbase) + (voff)[_i]), (LAS unsigned*)(lds + (bufoff) + ldsw + _i * 8192), 16, 0, 0); } while (0)
#define PG8_LDA(dst, b, h) do { _Pragma("unroll") for (int m = 0; m < 4; ++m) _Pragma("unroll") for (int k = 0; k < 2; ++k) dst[m][k] = *(const LAS bf16x8*)(lds + PG8_SA(b, h) + aoff + m * 2048 + k * 1024); } while (0)
#define PG8_LDB(dst, b, h) do { _Pragma("unroll") for (int n = 0; n < 2; ++n) _Pragma("unroll") for (int k = 0; k < 2; ++k) dst[n][k] = *(const LAS bf16x8*)(lds + PG8_SB(b, h) + boff + n * 2048 + k * 1024); } while (0)
#define PG8_MMA(ai, bj, At, Bt) do { __builtin_amdgcn_s_setprio(1); _Pragma("unroll") for (int m = 0; m < 4; ++m) _Pragma("unroll") for (int n = 0; n < 2; ++n) _Pragma("unroll") for (int k = 0; k < 2; ++k) \
        acc[ai][bj][m][n] = MFMA16(Bt[n][k], At[m][k], acc[ai][bj][m][n]); __builtin_amdgcn_s_setprio(0); } while (0)
#define PG8_WAIT_V(n) asm volatile("s_waitcnt vmcnt(" #n ")" ::: "memory")
#define PG8_WAIT_L(n) asm volatile("s_waitcnt lgkmcnt(" #n ")" ::: "memory")
#define PG8_BAR __builtin_amdgcn_s_barrier()
#define PG8_SCHED __builtin_amdgcn_sched_barrier(0)
    Unit cur, nxt; int ui = 0;
    if (!S.next(0, cur)) return;
    LAS float* rcache = (LAS float*)(lds + STAGE_BYTES) + wid * 128;
    int cached_pm = -1;
    f32x4 acc[2][2][4][2];
#pragma unroll
    for (int a = 0; a < 2; ++a)
#pragma unroll
        for (int b = 0; b < 2; ++b)
#pragma unroll
            for (int m = 0; m < 4; ++m)
#pragma unroll
                for (int n = 0; n < 2; ++n) acc[a][b][m][n] = (f32x4){0.f, 0.f, 0.f, 0.f};
    bf16x8 At[4][2], B0[2][2], B1[2][2];
    const char* cA = (const char*)g.A + (size_t)cur.pm * tsA + (size_t)cur.pn * g.acol_step; const char* cB = (const char*)g.Bt + (size_t)cur.pn * tsB;
    PG8_STAGE(PG8_SB(0, 0), cB, voffB); PG8_STAGE(PG8_SB(0, 1), cB + hsB, voffB); PG8_STAGE(PG8_SA(0, 0), cA, voffA); PG8_STAGE(PG8_SA(0, 1), cA + hsA, voffA);
    if (wr == 1) PG8_BAR;
    PG8_WAIT_V(2); PG8_BAR;
    PG8_STAGE(PG8_SB(1, 0), cB + kstep, voffB); PG8_STAGE(PG8_SA(1, 0), cA + kstep, voffA); PG8_STAGE(PG8_SB(1, 1), cB + hsB + kstep, voffB);
    PG8_WAIT_V(6); PG8_BAR;
    for (;;) {
        const bool has_next = S.next(ui + 1, nxt);
        const char* nA = has_next ? (const char*)g.A + (size_t)nxt.pm * tsA + (size_t)nxt.pn * g.acol_step : cA; const char* nB = has_next ? (const char*)g.Bt + (size_t)nxt.pn * tsB : cB;
#pragma unroll 1
        for (int t = 0; t < nt; t += 2) {
            const bool last = (t == nt - 2);
            const char* a1 = cA + (size_t)(t + 1) * kstep;
            const char* a2 = last ? nA : cA + (size_t)(t + 2) * kstep; const char* b2 = last ? nB : cB + (size_t)(t + 2) * kstep;
            const char* a3 = a2 + kstep; const char* b3 = b2 + kstep;
            PG8_LDB(B0, 0, 0); PG8_LDB(B1, 0, 1); PG8_SCHED; PG8_LDA(At, 0, 0); PG8_STAGE(PG8_SA(1, 1), a1 + hsA, voffA);
            PG8_WAIT_V(8); PG8_WAIT_L(0); PG8_BAR; PG8_MMA(0, 0, At, B0); PG8_MMA(0, 1, At, B1); PG8_BAR; PG8_SCHED;
            PG8_LDA(At, 0, 1); PG8_STAGE(PG8_SB(0, 0), b2, voffB); PG8_STAGE(PG8_SB(0, 1), b2 + hsB, voffB); PG8_STAGE(PG8_SA(0, 0), a2, voffA);
            PG8_WAIT_V(8); PG8_WAIT_L(0); PG8_BAR; PG8_MMA(1, 0, At, B0); PG8_MMA(1, 1, At, B1); PG8_BAR; PG8_SCHED;
            PG8_LDB(B0, 1, 0); PG8_LDB(B1, 1, 1); PG8_SCHED; PG8_LDA(At, 1, 0); PG8_STAGE(PG8_SA(0, 1), a2 + hsA, voffA);
            PG8_WAIT_V(8); PG8_WAIT_L(0); PG8_BAR; PG8_MMA(0, 0, At, B0); PG8_MMA(0, 1, At, B1); PG8_BAR; PG8_SCHED;
            PG8_LDA(At, 1, 1); PG8_STAGE(PG8_SB(1, 0), b3, voffB); PG8_STAGE(PG8_SB(1, 1), b3 + hsB, voffB); PG8_STAGE(PG8_SA(1, 0), a3, voffA);
            PG8_WAIT_V(8); PG8_WAIT_L(0); PG8_BAR; PG8_MMA(1, 0, At, B0); PG8_MMA(1, 1, At, B1); PG8_BAR; PG8_SCHED;
        }
        if (wr == 0) PG8_BAR;
        E(acc, cur, wr, wc, fr, fq, rcache, cached_pm);
        if (!has_next) break;
#pragma unroll
        for (int a = 0; a < 2; ++a)
#pragma unroll
            for (int b = 0; b < 2; ++b)
#pragma unroll
                for (int m = 0; m < 4; ++m)
#pragma unroll
                    for (int n = 0; n < 2; ++n) acc[a][b][m][n] = (f32x4){0.f, 0.f, 0.f, 0.f};
        cur = nxt; cA = nA; cB = nB; ++ui;
        if (wr == 1) PG8_BAR;
    }
    PG8_WAIT_V(0);
    PG8_BAR;
#undef PG8_SA
#undef PG8_SB
#undef PG8_STAGE
#undef PG8_LDA
#undef PG8_LDB
#undef PG8_MMA
#undef PG8_WAIT_V
#undef PG8_WAIT_L
#undef PG8_BAR
#undef PG8_SCHED
}
}

typedef f32x4 Acc[2][2][4][2];
template <class T> __device__ __forceinline__ T* at(const void* base, unsigned byteoff) { return (T*)((char*)base + byteoff); }

__device__ __forceinline__ float row_rstd(const float* ssq, int row, int fq) {
    const f32x4 v = *at<const f32x4>(ssq, (unsigned)(row * 16 + fq * 4) * 4u);
    float s = (v[0] + v[1]) + (v[2] + v[3]);
    s += swz_xor<16>(s); s = sum_x32(s);
    return rsqrtf(s * (1.0f / 1024.0f) + RMS_EPS);
}

__device__ __forceinline__ void load_rstd8(const float* ssq, int row0, int fq, float (&rs)[8]) {
    f32x4 v[8];
#pragma unroll
    for (int i = 0; i < 8; ++i) v[i] = *at<const f32x4>(ssq, (unsigned)((row0 + (i >> 2) * 128 + (i & 3) * 16) * 16 + fq * 4) * 4u);
#pragma unroll
    for (int i = 0; i < 8; ++i) { float t = (v[i][0] + v[i][1]) + (v[i][2] + v[i][3]); t += swz_xor<16>(t); t = sum_x32(t); rs[i] = rsqrtf(t * (1.0f / 1024.0f) + RMS_EPS); }
}

__device__ __forceinline__ void get_rstd8(const float* ssq, int pm, int row0, int fr, int fq, LAS float* rcache, int& cached_pm, float (&rs)[8]) {
    if (pm == cached_pm) {
#pragma unroll
        for (int i = 0; i < 8; ++i) rs[i] = rcache[i * 16 + fr];
    } else {
        load_rstd8(ssq, row0, fq, rs);
        if (fq == 0) {
#pragma unroll
            for (int i = 0; i < 8; ++i) rcache[i * 16 + fr] = rs[i];
        }
        cached_pm = pm;
    }
}

struct EpiGU {
    bf16_t* O; const float* ssq;
    __device__ __forceinline__ void operator()(const Acc& acc, const pg8::Unit& u, int wr, int wc, int fr, int fq, LAS float* rcache, int& cached_pm) const {
        const int row0 = u.pm * 256 + wr * 64 + fr, col0 = u.pn * 128 + wc * 32 + 8 * fq;
        float rs8[8]; get_rstd8(ssq, u.pm, row0, fr, fq, rcache, cached_pm, rs8);
#pragma unroll
        for (int ai = 0; ai < 2; ++ai)
#pragma unroll
            for (int m = 0; m < 4; ++m) {
                const int row = row0 + ai * 128 + m * 16; const float rs = rs8[ai * 4 + m], nrl = rs * -1.4426950408889634f, rs2 = rs * rs;
                f32x4 o[2];
#pragma unroll
                for (int n = 0; n < 2; ++n) { const f32x4 gv = acc[ai][0][m][n], uv = acc[ai][1][m][n]; const f32x4 t = gv * nrl; f32x4 e;
#pragma unroll
                    for (int j = 0; j < 4; ++j) e[j] = __builtin_amdgcn_exp2f(t[j]);
                    e = e + 1.0f; f32x4 r;
#pragma unroll
                    for (int j = 0; j < 4; ++j) r[j] = __builtin_amdgcn_rcpf(e[j]);
                    o[n] = ((gv * uv) * rs2) * r; }
#if USE_FP16
                *at<u32x4>(O, (unsigned)(row * DFF + col0) * 2u) = pack8(o[0], o[1]) & 0xFFF8FFF8u;
#else
                __builtin_nontemporal_store(pack8(o[0], o[1]), at<u32x4>(O, (unsigned)(row * DFF + col0) * 2u));
#endif
            }
    }
};

struct EpiRes {
    bf16_t* hb; float* ssq; float scale;
    __device__ __forceinline__ void operator()(const Acc& acc, const pg8::Unit& u, int wr, int wc, int fr, int fq, LAS float* rcache, int& cached_pm) const {
        const int row0 = u.pm * 256 + wr * 64 + fr, col0 = u.pn * 256 + wc * 32 + 8 * fq;
#pragma unroll
        for (int ai = 0; ai < 2; ++ai) {
            u32x4 rw[4][2];
#pragma unroll
            for (int m = 0; m < 4; ++m)
#pragma unroll
                for (int bj = 0; bj < 2; ++bj) rw[m][bj] = *at<const u32x4>(hb, (unsigned)((row0 + ai * 128 + m * 16) * DM + col0 + bj * 128) * 2u);
#pragma unroll
            for (int m = 0; m < 4; ++m) {
                const int row = row0 + ai * 128 + m * 16; const unsigned off = (unsigned)(row * DM + col0); float ss = 0.f;
#pragma unroll
                for (int bj = 0; bj < 2; ++bj) {
                    const u32x4 w = rw[m][bj];
                    const f32x4 r0 = (f32x4){bf_lo(w.x), bf_hi(w.x), bf_lo(w.y), bf_hi(w.y)}, r1 = (f32x4){bf_lo(w.z), bf_hi(w.z), bf_lo(w.w), bf_hi(w.w)};
                    const f32x4 v0 = r0 + acc[ai][bj][m][0] * scale, v1 = r1 + acc[ai][bj][m][1] * scale;
                    *at<u32x4>(hb, (off + bj * 128) * 2u) = pack8_rne(v0, v1);
                    ss += (v0[0] * v0[0] + v0[1] * v0[1]) + (v0[2] * v0[2] + v0[3] * v0[3]) + (v1[0] * v1[0] + v1[1] * v1[1]) + (v1[2] * v1[2] + v1[3] * v1[3]);
                }
                ss += swz_xor<16>(ss); ss = sum_x32(ss);
                if (fq == 0) *at<float>(ssq, (unsigned)(row * 16 + u.pn * 4 + wc) * 4u) = ss;
            }
        }
    }
};

struct EpiEvenIn {
    bf16_t* q; bf16_t* kv; bf16_t* glu; const float* ssq;
    __device__ __forceinline__ void operator()(const Acc& acc, const pg8::Unit& u, int wr, int wc, int fr, int fq, LAS float* rcache, int& cached_pm) const {
        const int row0 = u.pm * 256 + wr * 64 + fr, cl = wc * 32 + 8 * fq, pn = u.pn;
        float rs8[8]; get_rstd8(ssq, u.pm, row0, fr, fq, rcache, cached_pm, rs8);
        if (pn < 3) {
            bf16_t* base = pn < 2 ? q + pn * 256 : kv; const int ld = pn < 2 ? 512 : 256; const float sc = pn < 2 ? 0.125f * 1.4426950408889634f : 1.0f;
#pragma unroll
            for (int ai = 0; ai < 2; ++ai)
#pragma unroll
                for (int m = 0; m < 4; ++m) {
                    const int row = row0 + ai * 128 + m * 16; const float s = rs8[ai * 4 + m] * sc;
#pragma unroll
                    for (int bj = 0; bj < 2; ++bj) *at<u32x4>(base, (unsigned)(row * ld + bj * 128 + cl) * 2u) = pack8(acc[ai][bj][m][0] * s, acc[ai][bj][m][1] * s);
                }
        } else {
            bf16_t* base = glu + (pn - 3) * 128;
#pragma unroll
            for (int ai = 0; ai < 2; ++ai)
#pragma unroll
                for (int m = 0; m < 4; ++m) {
                    const int row = row0 + ai * 128 + m * 16; const float rs = rs8[ai * 4 + m];
                    f32x4 o[2];
#pragma unroll
                    for (int n = 0; n < 2; ++n) { const f32x4 av = acc[ai][0][m][n] * rs, bv = acc[ai][1][m][n] * rs;
#pragma unroll
                        for (int j = 0; j < 4; ++j) o[n][j] = av[j] * sigmoid_f(bv[j]); }
                    *at<u32x4>(base, (unsigned)(row * 512 + cl) * 2u) = pack8(o[0], o[1]);
                }
        }
    }
};

struct EpiOddIn {
    bf16_t* gate; bf16_t* urec; const float* ssq;
    __device__ __forceinline__ void operator()(const Acc& acc, const pg8::Unit& u, int wr, int wc, int fr, int fq, LAS float* rcache, int& cached_pm) const {
        const int row0 = u.pm * 256 + wr * 64 + fr, cl = wc * 32 + 8 * fq, pn = u.pn;
        float rs8[8]; get_rstd8(ssq, u.pm, row0, fr, fq, rcache, cached_pm, rs8);
        if (pn < 4) {
            bf16_t* base = gate + pn * 256;
#pragma unroll
            for (int ai = 0; ai < 2; ++ai)
#pragma unroll
                for (int m = 0; m < 4; ++m) {
                    const int row = row0 + ai * 128 + m * 16; const float rs = rs8[ai * 4 + m];
#pragma unroll
                    for (int bj = 0; bj < 2; ++bj) {
                        f32x4 v0 = acc[ai][bj][m][0] * rs, v1 = acc[ai][bj][m][1] * rs;
#pragma unroll
                        for (int j = 0; j < 4; ++j) { v0[j] = gelu_tanh_f(v0[j]); v1[j] = gelu_tanh_f(v1[j]); }
                        *at<u32x4>(base, (unsigned)(row * DM + bj * 128 + cl) * 2u) = pack8(v0, v1);
                    }
                }
        } else {
            bf16_t* base = urec + (pn - 4) * 256;
#pragma unroll
            for (int ai = 0; ai < 2; ++ai)
#pragma unroll
                for (int m = 0; m < 4; ++m) {
                    const int row = row0 + ai * 128 + m * 16; const float rs = rs8[ai * 4 + m];
#pragma unroll
                    for (int bj = 0; bj < 2; ++bj) *at<u32x4>(base, (unsigned)(row * DM + bj * 128 + cl) * 2u) = pack8(acc[ai][bj][m][0] * rs, acc[ai][bj][m][1] * rs);
                }
        }
    }
};

struct EpiLru {
    const bf16_t* xc; bf16_t* om; bf16_t* bx; const float* ga_b; const float* gx_b; const float* lsl;
    __device__ __forceinline__ void operator()(const Acc& acc, const pg8::Unit& u, int wr, int wc, int fr, int fq, LAS float* rcache, int& cached_pm) const {
        const int row0 = u.pm * 256 + wr * 64 + fr, col0 = u.pn * 128 + wc * 32 + 8 * fq;
        f32x4 ba[2], bb[2], ls[2]; u32x4 xw[8];
#pragma unroll
        for (int n = 0; n < 2; ++n) { ba[n] = *at<const f32x4>(ga_b, (unsigned)(col0 + 4 * n) * 4u); bb[n] = *at<const f32x4>(gx_b, (unsigned)(col0 + 4 * n) * 4u); ls[n] = *at<const f32x4>(lsl, (unsigned)(col0 + 4 * n) * 4u); }
#pragma unroll
        for (int i = 0; i < 8; ++i) xw[i] = *at<const u32x4>(xc, (unsigned)((row0 + (i >> 2) * 128 + (i & 3) * 16) * DM + col0) * 2u);
#pragma unroll
        for (int ai = 0; ai < 2; ++ai)
#pragma unroll
            for (int m = 0; m < 4; ++m) {
                const int row = row0 + ai * 128 + m * 16; const unsigned off = (unsigned)(row * DM + col0);
                f32x4 ov[2], bv[2];
#pragma unroll
                for (int n = 0; n < 2; ++n)
#pragma unroll
                    for (int j = 0; j < 4; ++j) {
                        const unsigned w = xw[ai * 4 + m][n * 2 + (j >> 1)]; const float xv = (j & 1) ? bf_hi(w) : bf_lo(w);
                        const float r = sigmoid_f(acc[ai][0][m][n][j] + ba[n][j]), ig = sigmoid_f(acc[ai][1][m][n][j] + bb[n][j]);
                        const float aa = __expf(r * (8.0f * ls[n][j]));
                        ov[n][j] = 1.0f - aa; bv[n][j] = __builtin_amdgcn_sqrtf(fmaxf(1.0f - aa * aa, 0.f)) * (ig * xv);
                    }
                *at<u32x4>(om, off * 2u) = pack8(ov[0], ov[1]);
                *at<u32x4>(bx, off * 2u) = pack8(bv[0], bv[1]);
            }
    }
};

__device__ __forceinline__ void transpose_tile(const float* W, int ldw, const float* gain, bf16_t* WT, int ldt, int k0, int n0, int drow0, LAS float* scr, int lane) {
    const int r = lane >> 4, c4 = lane & 15;
    f32x4 v[16];
#pragma unroll
    for (int i = 0; i < 16; ++i) v[i] = *(const f32x4*)(W + (size_t)(k0 + 4 * i + r) * ldw + n0 + 4 * c4);
    if (gain) {
#pragma unroll
        for (int i = 0; i < 16; ++i) v[i] = v[i] * gain[k0 + 4 * i + r];
    }
#pragma unroll
    for (int i = 0; i < 16; ++i)
#pragma unroll
        for (int j = 0; j < 4; ++j) scr[(4 * i + r) * 65 + 4 * c4 + j] = v[i][j];
    asm volatile("s_waitcnt lgkmcnt(0)" ::: "memory");
    const int c = lane & 7;
#pragma unroll
    for (int jj = 0; jj < 8; ++jj) { const int n = (lane >> 3) + 8 * jj; const LAS float* sp = scr + (8 * c) * 65 + n;
        u32x4 o; o.x = cvt_pk_w(sp[0 * 65], sp[1 * 65]); o.y = cvt_pk_w(sp[2 * 65], sp[3 * 65]); o.z = cvt_pk_w(sp[4 * 65], sp[5 * 65]); o.w = cvt_pk_w(sp[6 * 65], sp[7 * 65]);
        *(u32x4*)(WT + (size_t)(drow0 + n) * ldt + k0 + 8 * c) = o; }
    asm volatile("s_waitcnt lgkmcnt(0)" ::: "memory");
}

struct Args { const float* in[28]; float* out; unsigned char* ws; };

__device__ __forceinline__ void prologue(const Args& A, LAS unsigned char* lds, int tid, int G) {
    const int lane = tid & 63, wave = tid >> 6;
    unsigned char* ws = A.ws;
    LAS float* scr = (LAS float*)(lds + wave * 16640);
    const int gw = blockIdx.x * 8 + wave, NGW = G * 8;
    constexpr int NI_FFN = 8 * 2112, NI_EVEN = 2 * 704, NI_ODD = 2 * 768;
    for (int it = gw; it < NI_FFN + NI_EVEN + NI_ODD; it += NGW) {
        if (it < NI_FFN) {
            const int f = it / 2112, r = it % 2112, layer = f >> 1, which = f & 1, mat = r / 704, r2 = r % 704;
            bf16_t* wgu = (bf16_t*)(ws + WS_FFN + (size_t)f * FFN_STRIDE); bf16_t* wd = (bf16_t*)(ws + WS_FFN + (size_t)f * FFN_STRIDE + WGU_BYTES);
            if (mat < 2) {
                const float* W = A.in[(which ? 7 : 2) + mat] + (size_t)layer * DM * DFF; const float* gain = A.in[which ? 6 : 1] + layer * DM;
                const int kb = r2 / 44, nb = r2 % 44, n0 = nb * 64, drow0 = (n0 >> 7) * 256 + mat * 128 + (n0 & 127);
                transpose_tile(W, DFF, gain, wgu, DM, kb * 64, n0, drow0, scr, lane);
            } else {
                const float* W = A.in[which ? 9 : 4] + (size_t)layer * DFF * DM;
                const int kb = r2 / 16, nb = r2 % 16;
                transpose_tile(W, DM, nullptr, wd, DFF, kb * 64, nb * 64, nb * 64, scr, lane);
            }
        } else if (it < NI_FFN + NI_EVEN) {
            const int q = it - NI_FFN, e = q / 704, r = q % 704;
            bf16_t* win = (bf16_t*)(ws + WS_EVEN + (size_t)e * EVEN_STRIDE); bf16_t* wout = (bf16_t*)(ws + WS_EVEN + (size_t)e * EVEN_STRIDE + EVEN_WIN_BYTES);
            if (r < 448) {
                const int kb = r / 28, nb = r % 28, n0 = nb * 64; int drow0;
                if (n0 < 768) drow0 = n0; else if (n0 < 1280) { const int c = n0 - 768; drow0 = 768 + (c >> 7) * 256 + (c & 127); } else { const int c = n0 - 1280; drow0 = 768 + (c >> 7) * 256 + 128 + (c & 127); }
                transpose_tile(A.in[11] + (size_t)e * DM * EVEN_IN, EVEN_IN, A.in[5] + (2 * e) * DM, win, DM, kb * 64, n0, drow0, scr, lane);
            } else {
                const int r2 = r - 448, kb = r2 / 16, nb = r2 % 16;
                transpose_tile(A.in[17] + (size_t)e * DM * DM, DM, nullptr, wout, DM, kb * 64, nb * 64, nb * 64, scr, lane);
            }
        } else {
            const int q = it - NI_FFN - NI_EVEN, o = q / 768, r = q % 768;
            bf16_t* win = (bf16_t*)(ws + WS_ODD + (size_t)o * ODD_STRIDE); bf16_t* wout = (bf16_t*)(ws + WS_ODD + (size_t)o * ODD_STRIDE + 4 * MiB);
            if (r < 512) {
                const int kb = r / 32, nb = r % 32;
                transpose_tile(A.in[18] + (size_t)o * DM * 2048, 2048, A.in[5] + (2 * o + 1) * DM, win, DM, kb * 64, nb * 64, nb * 64, scr, lane);
            } else {
                const int r2 = r - 512, kb = r2 / 16, nb = r2 % 16;
                transpose_tile(A.in[26] + (size_t)o * DM * DM, DM, nullptr, wout, DM, kb * 64, nb * 64, nb * 64, scr, lane);
            }
        }
    }
    {
        const int gt = blockIdx.x * 512 + tid, NT = G * 512;
        for (int idx = gt; idx < 2 * 8 * 256 * 16; idx += NT) {
            const int k8 = idx & 15, row = (idx >> 4) & 255, h = (idx >> 12) & 7, o = idx >> 15;
            const int i0 = k8 * 8;
            const float* src = A.in[row < 128 ? 21 : 23] + ((size_t)(o * 8 + h) * 128 + i0) * 128 + (row & 127);
            u32x4 w; w.x = cvt_pk_w(src[0], src[128]); w.y = cvt_pk_w(src[256], src[384]); w.z = cvt_pk_w(src[512], src[640]); w.w = cvt_pk_w(src[768], src[896]);
            bf16_t* dst = (bf16_t*)(ws + WS_ODD + (size_t)o * ODD_STRIDE + 6 * MiB) + ((size_t)h * 256 + row) * 128 + i0;
            *(u32x4*)dst = w;
        }
        float* tab = (float*)(ws + WS_TAB);
        for (int idx = gt; idx < 2048 + 1024; idx += NT) {
            if (idx < 2048) { const float lam = A.in[25][idx]; tab[idx] = -log1pf(expf(-lam)); }
            else { const int j = idx - 2048, hd = j >> 7, dist = j & 127; int bucket;
                if (dist < 16) bucket = dist; else { bucket = 16 + (int)(logf((float)dist / 16.0f) / 2.0794415416798357f * 16.0f); if (bucket > 31) bucket = 31; }
                tab[idx] = A.in[10][bucket * 8 + hd]; }
        }
    }
    {
        const float* x = A.in[0]; bf16_t* hb = (bf16_t*)(ws + WS_HB); float* ssq = (float*)(ws + WS_SSQ);
        for (int row = gw; row < MTOK; row += 2 * NGW) {
            const int row1 = row + NGW; const bool has1 = row1 < MTOK; const int r1 = has1 ? row1 : row;
            const f32x4* xr0 = (const f32x4*)(x + (size_t)row * DM) + lane * 2; const f32x4* xr1 = (const f32x4*)(x + (size_t)r1 * DM) + lane * 2;
            f32x4 a0[2], b0[2], a1[2], b1[2]; float s0 = 0.f, s1 = 0.f;
#pragma unroll
            for (int j = 0; j < 2; ++j) { a0[j] = xr0[128 * j]; b0[j] = xr0[128 * j + 1]; a1[j] = xr1[128 * j]; b1[j] = xr1[128 * j + 1]; }
#pragma unroll
            for (int j = 0; j < 2; ++j) {
                s0 += (a0[j][0] * a0[j][0] + a0[j][1] * a0[j][1]) + (a0[j][2] * a0[j][2] + a0[j][3] * a0[j][3]) + (b0[j][0] * b0[j][0] + b0[j][1] * b0[j][1]) + (b0[j][2] * b0[j][2] + b0[j][3] * b0[j][3]);
                s1 += (a1[j][0] * a1[j][0] + a1[j][1] * a1[j][1]) + (a1[j][2] * a1[j][2] + a1[j][3] * a1[j][3]) + (b1[j][0] * b1[j][0] + b1[j][1] * b1[j][1]) + (b1[j][2] * b1[j][2] + b1[j][3] * b1[j][3]);
                *(u32x4*)(hb + (size_t)row * DM + j * 512 + lane * 8) = pack8_rne(a0[j], b0[j]);
                if (has1) *(u32x4*)(hb + (size_t)row1 * DM + j * 512 + lane * 8) = pack8_rne(a1[j], b1[j]); }
            { s0 = wave_sum(s0); s1 = wave_sum(s1); }
            if (lane < 4) { *(f32x4*)(ssq + (size_t)row * 16 + lane * 4) = (f32x4){lane == 0 ? s0 : 0.f, 0.f, 0.f, 0.f};
                if (has1) *(f32x4*)(ssq + (size_t)row1 * 16 + lane * 4) = (f32x4){lane == 0 ? s1 : 0.f, 0.f, 0.f, 0.f}; }
        }
    }
}

__device__ __forceinline__ int crow(int r, int hi) { return (r & 3) + 8 * (r >> 2) + 4 * hi; }

__device__ __forceinline__ void attn_phase(LAS unsigned char* lds, const bf16_t* q, const bf16_t* kv, bf16_t* cat, const float* btab, const float* sinks, int tid, int G) {
    asm volatile("" : "+v"(tid));
    const int lane = tid & 63, wave = tid >> 6, l31 = lane & 31, hi = lane >> 5;
    LAS bf16_t* Ks = (LAS bf16_t*)lds;
    LAS bf16_t* Vt = (LAS bf16_t*)(lds + 36864);
    LAS float* btx = (LAS float*)(lds + 36864 + 33792);
    const int g = wave >> 1;
    const float LOG2E = 1.4426950408889634f;
    for (int i = tid; i < 8 * 192; i += 512) { const int hh = i / 192, x = i % 192, dist = x - 32; btx[i] = (dist >= 0 && dist < 128) ? btab[hh * 128 + dist] * LOG2E : -1e30f; }
    for (int unit = blockIdx.x; unit < 1024; unit += G) {
        const int nbk = unit >> 1, n = nbk & 15, tok0 = nbk * 128, hku = unit & 1;
        const float sink = sinks[hku * 4 + g] * LOG2E;
        const LAS float* bp = btx + (hku * 4 + g) * 192 + 32 + (128 + l31 - 4 * hi) - 155;
        __syncthreads();
#pragma unroll
        for (int i = 0; i < 4; ++i) {
            const int c = tid + 512 * i, sj = c >> 3, ch = c & 7;
            u32x4 kw = (u32x4){0u, 0u, 0u, 0u};
            if (n > 0 || sj >= 128) kw = *at<const u32x4>(kv, (unsigned)((tok0 - 128 + sj) * 256 + hku * 64 + ch * 8) * 2u);
            *(LAS u32x4*)(Ks + sj * 72 + ch * 8) = kw;
        }
#pragma unroll
        for (int i = 0; i < 4; ++i) {
            const int c = tid + 512 * i, sj = c & 255, ch = c >> 8;
            u32x4 vw = (u32x4){0u, 0u, 0u, 0u};
            if (n > 0 || sj >= 128) vw = *at<const u32x4>(kv, (unsigned)((tok0 - 128 + sj) * 256 + 128 + hku * 64 + ch * 8) * 2u);
#pragma unroll
            for (int e = 0; e < 8; ++e) Vt[(ch * 8 + e) * 260 + sj] = (bf16_t)(vw[e >> 1] >> (16 * (e & 1)));
        }
        __syncthreads();
#pragma unroll 1
        for (int pair = 0; pair < 2; ++pair) {
            const int t = (wave & 1) * 2 + pair, qi = 32 * t + l31; const unsigned qrow = (unsigned)(tok0 + qi);
            bf16x8 qf[4];
#pragma unroll
            for (int st = 0; st < 4; ++st) qf[st] = *at<const bf16x8>(q, (unsigned)(qrow * 512 + (hku * 4 + g) * 64 + st * 16 + hi * 8) * 2u);
            f32x16 s[5];
#pragma unroll
            for (int k5 = 0; k5 < 5; ++k5) {
                s[k5] = (f32x16){0.f, 0.f, 0.f, 0.f, 0.f, 0.f, 0.f, 0.f, 0.f, 0.f, 0.f, 0.f, 0.f, 0.f, 0.f, 0.f};
#pragma unroll
                for (int st = 0; st < 4; ++st) { const bf16x8 kf = *(const LAS bf16x8*)(Ks + (32 * (t + k5) + l31) * 72 + st * 16 + hi * 8);
                    s[k5] = MFMA32(kf, qf[st], s[k5]); }
            }
            float mx = sink;
#pragma unroll
            for (int k5 = 0; k5 < 5; ++k5) {
                const bool dead = (n == 0) && (t + k5 < 4);
#pragma unroll
                for (int r = 0; r < 16; ++r) {
                    float v = s[k5][r] + bp[155 - (32 * k5 + crow(r, 0))];
                    v = dead ? -1e30f : v;
                    s[k5][r] = v; mx = fmaxf(mx, v);
                }
            }
            mx = max_x32(mx);
            float sum = 0.f;
#pragma unroll
            for (int k5 = 0; k5 < 5; ++k5)
#pragma unroll
                for (int r = 0; r < 16; ++r) { const float p = __builtin_amdgcn_exp2f(s[k5][r] - mx); s[k5][r] = p; sum += p; }
            sum = sum_x32(sum); sum += __builtin_amdgcn_exp2f(sink - mx);
            const float inv = 1.0f / sum;
            f32x16 o[2];
            o[0] = (f32x16){0.f, 0.f, 0.f, 0.f, 0.f, 0.f, 0.f, 0.f, 0.f, 0.f, 0.f, 0.f, 0.f, 0.f, 0.f, 0.f}; o[1] = o[0];
#pragma unroll
            for (int k5 = 0; k5 < 5; ++k5)
#pragma unroll
                for (int s2 = 0; s2 < 2; ++s2) {
                    u32x4 pw; pw.x = cvt_pk_rtz(s[k5][8 * s2 + 0], s[k5][8 * s2 + 1]); pw.y = cvt_pk_rtz(s[k5][8 * s2 + 2], s[k5][8 * s2 + 3]);
                    pw.z = cvt_pk_rtz(s[k5][8 * s2 + 4], s[k5][8 * s2 + 5]); pw.w = cvt_pk_rtz(s[k5][8 * s2 + 6], s[k5][8 * s2 + 7]);
                    const bf16x8 pb = __builtin_bit_cast(bf16x8, pw);
#pragma unroll
                    for (int dt = 0; dt < 2; ++dt) {
                        const LAS bf16_t* vp = Vt + (dt * 32 + l31) * 260 + 32 * (t + k5) + 16 * s2 + 4 * hi;
                        const u32x2 lo = *(const LAS u32x2*)vp, hh = *(const LAS u32x2*)(vp + 8);
                        const u32x4 vw = (u32x4){lo.x, lo.y, hh.x, hh.y};
                        o[dt] = MFMA32(__builtin_bit_cast(bf16x8, vw), pb, o[dt]);
                    }
                }
#pragma unroll
            for (int dt = 0; dt < 2; ++dt)
#pragma unroll
                for (int j = 0; j < 4; ++j) {
                    u32x2 w; w.x = cvt_pk_rtz(o[dt][4 * j] * inv, o[dt][4 * j + 1] * inv); w.y = cvt_pk_rtz(o[dt][4 * j + 2] * inv, o[dt][4 * j + 3] * inv);
                    *at<u32x2>(cat, (qrow * DM + (hku * 4 + g) * 64 + 32 * dt + 8 * j + 4 * hi) * 2u) = w;
                }
        }
    }
    __syncthreads();
}

typedef float f32x2 __attribute__((ext_vector_type(2)));
__device__ __forceinline__ void conv_phase(LAS unsigned char* lds, const bf16_t* glu, bf16_t* cat, const float* cw, const float* cb, const float* lg, const float* lb, int tid, int G) {
    asm volatile("" : "+v"(tid));
    const int lane = tid & 63, wave = tid >> 6, c = tid;
    LAS bf16_t* xin = (LAS bf16_t*)lds;
    LAS float* yb = (LAS float*)(lds + 63488);
    f32x2 E[16], O[16];
#pragma unroll
    for (int i = 0; i < 16; ++i) {
        const float we = (2 * i <= 30) ? cw[(2 * i) * 512 + c] : 0.f, wm = (2 * i - 1 >= 0) ? cw[(2 * i - 1) * 512 + c] : 0.f, wo = (2 * i + 1 <= 30) ? cw[(2 * i + 1) * 512 + c] : 0.f;
        E[i] = (f32x2){we, wm}; O[i] = (f32x2){wo, we};
    }
    const float bias = cb[c];
    const f32x4 g0 = *(const f32x4*)(lg + lane * 8), g1 = *(const f32x4*)(lg + lane * 8 + 4), b0 = *(const f32x4*)(lb + lane * 8), b1 = *(const f32x4*)(lb + lane * 8 + 4);
    u32x4 pf[8];
#define CONV_PREFETCH(tile_) do { const int t0_ = (tile_) * 32; const bool first_ = (t0_ & (SEQ - 1)) == 0; \
        _Pragma("unroll") for (int i = 0; i < 8; ++i) { const int ch = tid + 512 * i, r = ch >> 6, cc = ch & 63; pf[i] = (u32x4){0u, 0u, 0u, 0u}; \
            if (ch < 62 * 64 && !(first_ && r < 30)) pf[i] = *at<const u32x4>(glu, (unsigned)((t0_ - 30 + r) * 512 + cc * 8) * 2u); } } while (0)
    int tile = blockIdx.x;
    if (tile < MTOK / 32) CONV_PREFETCH(tile);
    for (; tile < MTOK / 32; tile += G) {
        const int t0 = tile * 32;
        __syncthreads();
#pragma unroll
        for (int i = 0; i < 8; ++i) { const int ch = tid + 512 * i, r = ch >> 6, cc = ch & 63; if (ch < 62 * 64) *(LAS u32x4*)(xin + r * 512 + cc * 8) = pf[i]; }
        __syncthreads();
        if (tile + G < MTOK / 32) CONV_PREFETCH(tile + G);
        f32x2 y2[16];
#pragma unroll
        for (int p = 0; p < 16; ++p) y2[p] = (f32x2){bias, bias};
#pragma unroll
        for (int r = 0; r < 62; ++r) { const float xv = bf2f(xin[r * 512 + c]); const f32x2 xv2 = (f32x2){xv, xv};
#pragma unroll
            for (int p = 0; p < 16; ++p) { const int k = r - 2 * p; if (k >= 0 && k <= 31) y2[p] = ((k & 1) ? O[(k - 1) / 2] : E[k / 2]) * xv2 + y2[p]; } }
#pragma unroll
        for (int p = 0; p < 16; ++p) { yb[(2 * p) * 512 + c] = y2[p].x; yb[(2 * p + 1) * 512 + c] = y2[p].y; }
        __syncthreads();
#pragma unroll
        for (int i = 0; i < 4; ++i) { const int tt = wave * 4 + i;
            f32x4 a = *(const LAS f32x4*)(yb + tt * 512 + lane * 8), b = *(const LAS f32x4*)(yb + tt * 512 + lane * 8 + 4);
            const float mean = wave_sum((a[0] + a[1]) + (a[2] + a[3]) + (b[0] + b[1]) + (b[2] + b[3])) * (1.0f / 512.0f);
            a = a - mean; b = b - mean;
            const float var = wave_sum((a[0] * a[0] + a[1] * a[1]) + (a[2] * a[2] + a[3] * a[3]) + (b[0] * b[0] + b[1] * b[1]) + (b[2] * b[2] + b[3] * b[3])) * (1.0f / 512.0f);
            const float rstd = rsqrtf(var + LN_EPS);
            a = a * rstd * g0 + b0; b = b * rstd * g1 + b1;
#pragma unroll
            for (int j = 0; j < 4; ++j) { a[j] = silu_f(a[j]); b[j] = silu_f(b[j]); }
            *(u32x4*)(cat + (size_t)(t0 + tt) * DM + 512 + lane * 8) = pack8(a, b); }
    }
#undef CONV_PREFETCH
    __syncthreads();
}

__device__ __forceinline__ void conv4_phase(const bf16_t* urec, bf16_t* xc, const float* cw, const float* cb, int tid, int G) {
    asm volatile("" : "+v"(tid));
    const int gt = blockIdx.x * 512 + tid, NT = G * 512;
    for (int it = gt; it < (MTOK / 16) * 128; it += NT) {
        const int cgp = it & 127, run = it >> 7, t0 = run * 16, c0 = cgp * 8;
        float w[4][8], b[8], x0[8], x1[8], x2[8];
#pragma unroll
        for (int k = 0; k < 4; ++k) { const f32x4 a = *(const f32x4*)(cw + k * DM + c0), bq = *(const f32x4*)(cw + k * DM + c0 + 4);
#pragma unroll
            for (int j = 0; j < 4; ++j) { w[k][j] = a[j]; w[k][4 + j] = bq[j]; } }
        { const f32x4 a = *(const f32x4*)(cb + c0), bq = *(const f32x4*)(cb + c0 + 4);
#pragma unroll
            for (int j = 0; j < 4; ++j) { b[j] = a[j]; b[4 + j] = bq[j]; } }
#pragma unroll
        for (int j = 0; j < 8; ++j) { x0[j] = 0.f; x1[j] = 0.f; x2[j] = 0.f; }
        if ((t0 & (SEQ - 1)) != 0) {
            const u32x4 a = *(const u32x4*)(urec + (size_t)(t0 - 3) * DM + c0), bq = *(const u32x4*)(urec + (size_t)(t0 - 2) * DM + c0), cq = *(const u32x4*)(urec + (size_t)(t0 - 1) * DM + c0);
#pragma unroll
            for (int j = 0; j < 4; ++j) { x0[2 * j] = bf_lo(a[j]); x0[2 * j + 1] = bf_hi(a[j]); x1[2 * j] = bf_lo(bq[j]); x1[2 * j + 1] = bf_hi(bq[j]); x2[2 * j] = bf_lo(cq[j]); x2[2 * j + 1] = bf_hi(cq[j]); }
        }
#pragma unroll 8
        for (int tt = 0; tt < 16; ++tt) {
            const u32x4 a = *(const u32x4*)(urec + (size_t)(t0 + tt) * DM + c0);
            float x3[8], y[8];
#pragma unroll
            for (int j = 0; j < 4; ++j) { x3[2 * j] = bf_lo(a[j]); x3[2 * j + 1] = bf_hi(a[j]); }
#pragma unroll
            for (int j = 0; j < 8; ++j) y[j] = b[j] + w[0][j] * x0[j] + w[1][j] * x1[j] + w[2][j] * x2[j] + w[3][j] * x3[j];
            u32x4 o; o.x = cvt_pk_rtz(y[0], y[1]); o.y = cvt_pk_rtz(y[2], y[3]); o.z = cvt_pk_rtz(y[4], y[5]); o.w = cvt_pk_rtz(y[6], y[7]);
            *(u32x4*)(xc + (size_t)(t0 + tt) * DM + c0) = o;
#pragma unroll
            for (int j = 0; j < 8; ++j) { x0[j] = x1[j]; x1[j] = x2[j]; x2[j] = x3[j]; }
        }
    }
}

__device__ __forceinline__ void scan_phase(LAS unsigned char* lds, const bf16_t* om, const bf16_t* bx, const bf16_t* gate, bf16_t* y, int tid, int G) {
    asm volatile("" : "+v"(tid));
    LAS float* PS = (LAS float*)lds;
    const int cq = tid & 15, chunk = tid >> 4;
    for (int item = blockIdx.x; item < 512; item += G) {
        const int b = item >> 4, cgp = item & 15;
        const unsigned base = (unsigned)(((b * SEQ + chunk * 64) * DM + cgp * 64 + cq * 4) * 2);
        float P[4] = {1.f, 1.f, 1.f, 1.f}, S[4] = {0.f, 0.f, 0.f, 0.f};
        for (int t = 0; t < 64; t += 8) {
            u32x2 ow[8], bw[8];
#pragma unroll
            for (int i = 0; i < 8; ++i) { ow[i] = *at<const u32x2>(om, base + (unsigned)(t + i) * (DM * 2)); bw[i] = *at<const u32x2>(bx, base + (unsigned)(t + i) * (DM * 2)); }
#pragma unroll
            for (int i = 0; i < 8; ++i) {
                const float a0 = 1.0f - bf_lo(ow[i].x), a1 = 1.0f - bf_hi(ow[i].x), a2 = 1.0f - bf_lo(ow[i].y), a3 = 1.0f - bf_hi(ow[i].y);
                P[0] *= a0; P[1] *= a1; P[2] *= a2; P[3] *= a3;
                S[0] = a0 * S[0] + bf_lo(bw[i].x); S[1] = a1 * S[1] + bf_hi(bw[i].x); S[2] = a2 * S[2] + bf_lo(bw[i].y); S[3] = a3 * S[3] + bf_hi(bw[i].y);
            }
        }
        __syncthreads();
#pragma unroll
        for (int j = 0; j < 4; ++j) { PS[(chunk * 64 + cq * 4 + j) * 2] = P[j]; PS[(chunk * 64 + cq * 4 + j) * 2 + 1] = S[j]; }
        __syncthreads();
        float h[4] = {0.f, 0.f, 0.f, 0.f};
        for (int c = 0; c < chunk; ++c) {
#pragma unroll
            for (int j = 0; j < 4; ++j) h[j] = PS[(c * 64 + cq * 4 + j) * 2] * h[j] + PS[(c * 64 + cq * 4 + j) * 2 + 1];
        }
        for (int t = 0; t < 64; t += 8) {
            u32x2 ow[8], bw[8], gw[8];
#pragma unroll
            for (int i = 0; i < 8; ++i) { ow[i] = *at<const u32x2>(om, base + (unsigned)(t + i) * (DM * 2)); bw[i] = *at<const u32x2>(bx, base + (unsigned)(t + i) * (DM * 2)); gw[i] = *at<const u32x2>(gate, base + (unsigned)(t + i) * (DM * 2)); }
#pragma unroll
            for (int i = 0; i < 8; ++i) {
                h[0] = (1.0f - bf_lo(ow[i].x)) * h[0] + bf_lo(bw[i].x); h[1] = (1.0f - bf_hi(ow[i].x)) * h[1] + bf_hi(bw[i].x);
                h[2] = (1.0f - bf_lo(ow[i].y)) * h[2] + bf_lo(bw[i].y); h[3] = (1.0f - bf_hi(ow[i].y)) * h[3] + bf_hi(bw[i].y);
                u32x2 o; o.x = cvt_pk_rtz(bf_lo(gw[i].x) * h[0], bf_hi(gw[i].x) * h[1]); o.y = cvt_pk_rtz(bf_lo(gw[i].y) * h[2], bf_hi(gw[i].y) * h[3]);
                *at<u32x2>(y, base + (unsigned)(t + i) * (DM * 2)) = o;
            }
        }
    }
    __syncthreads();
}

__device__ __forceinline__ void final_norm(const bf16_t* hb, float* out, const float* gain, int tid, int G) {
    asm volatile("" : "+v"(tid));
    const int lane = tid & 63, wave = tid >> 6, gw = blockIdx.x * 8 + wave, NGW = G * 8;
    f32x4 gv[4];
#pragma unroll
    for (int j = 0; j < 4; ++j) gv[j] = *(const f32x4*)(gain + j * 256 + lane * 4);
    for (int row = gw; row < MTOK; row += 2 * NGW) {
        const int row1 = row + NGW; const bool has1 = row1 < MTOK;
        const u32x2* hr0 = (const u32x2*)(hb + (size_t)row * DM) + lane; const u32x2* hr1 = (const u32x2*)(hb + (size_t)(has1 ? row1 : row) * DM) + lane;
        f32x4 v0[4], v1[4]; float s0 = 0.f, s1 = 0.f;
#pragma unroll
        for (int j = 0; j < 4; ++j) { const u32x2 w0 = hr0[64 * j], w1 = hr1[64 * j];
            v0[j] = (f32x4){bf_lo(w0.x), bf_hi(w0.x), bf_lo(w0.y), bf_hi(w0.y)}; v1[j] = (f32x4){bf_lo(w1.x), bf_hi(w1.x), bf_lo(w1.y), bf_hi(w1.y)};
            s0 += (v0[j][0] * v0[j][0] + v0[j][1] * v0[j][1]) + (v0[j][2] * v0[j][2] + v0[j][3] * v0[j][3]); s1 += (v1[j][0] * v1[j][0] + v1[j][1] * v1[j][1]) + (v1[j][2] * v1[j][2] + v1[j][3] * v1[j][3]); }
        { s0 = wave_sum(s0); s1 = wave_sum(s1); }
        const float rs0 = rsqrtf(s0 * (1.0f / 1024.0f) + RMS_EPS), rs1 = rsqrtf(s1 * (1.0f / 1024.0f) + RMS_EPS);
        f32x4* o0 = (f32x4*)(out + (size_t)row * DM) + lane;
#pragma unroll
        for (int j = 0; j < 4; ++j) o0[64 * j] = v0[j] * rs0 * gv[j];
        if (has1) { f32x4* o1 = (f32x4*)(out + (size_t)row1 * DM) + lane;
#pragma unroll
            for (int j = 0; j < 4; ++j) o1[64 * j] = v1[j] * rs1 * gv[j]; }
    }
}

#define XB_TMO      128
#define XB_XCNT(j)  (256  + 64 * (j))
#define XB_XSUB(j)  (1280 + 64 * (j))
#define XB_XGEN(j)  (2304 + 64 * (j))
#define XB_TOP      3328
#define XB_TOPGEN   3392
#define XCD_BAR_WORDS 3456
#define XB_SPIN_CAP (1u << 18)
__device__ __forceinline__ unsigned xb_ld(unsigned* p)              { return __hip_atomic_load(p, __ATOMIC_RELAXED, __HIP_MEMORY_SCOPE_AGENT); }
__device__ __forceinline__ unsigned xb_add(unsigned* p, unsigned v) { return __hip_atomic_fetch_add(p, v, __ATOMIC_RELAXED, __HIP_MEMORY_SCOPE_AGENT); }
__device__ __forceinline__ unsigned xb_xcc_id() { return (unsigned)__builtin_amdgcn_s_getreg((3 << 11) | 20) & 0xFu; }
#define XB_SPIN(cond, bar) do { unsigned _sp = 0; while (cond) { __builtin_amdgcn_s_sleep(1); \
    if ((++_sp & 255u) == 0u) { if (xb_ld(&(bar)[XB_TMO])) break; if (_sp > XB_SPIN_CAP) { atomicAdd(&(bar)[XB_TMO], 1u); break; } } } } while (0)
struct XcdBarrier { unsigned* bar; unsigned x; volatile LAS unsigned* st; };
__device__ __forceinline__ XcdBarrier xcd_barrier_post(unsigned* bar, volatile LAS unsigned* st) {
    XcdBarrier b; b.bar = bar; b.x = xb_xcc_id(); b.st = st;
    if (threadIdx.x == 0) (void)xb_add(&bar[XB_XCNT(b.x)], 1u);
    return b;
}
__device__ __forceinline__ void xcd_barrier_complete(unsigned* bar, unsigned x, unsigned& nloc, unsigned& nx) {
    const unsigned G = gridDim.x * gridDim.y * gridDim.z;
    unsigned sum, cnt, mine, sp = 0u;
    for (;;) {
        sum = 0u; cnt = 0u; mine = 0u;
#pragma unroll
        for (unsigned j = 0; j < 16; ++j) { const unsigned c = xb_ld(&bar[XB_XCNT(j)]); sum += c; cnt += (c > 0u) ? 1u : 0u; mine = (j == x) ? c : mine; }
        if (sum == G) break;
        __builtin_amdgcn_s_sleep(1);
        if ((++sp & 255u) == 0u) { if (xb_ld(&bar[XB_TMO])) break; if (sp > XB_SPIN_CAP) { atomicAdd(&bar[XB_TMO], 1u); break; } }
    }
    nloc = mine > 0u ? mine : 1u; nx = cnt > 0u ? cnt : 1u;
}
__device__ __forceinline__ void xcd_barrier(unsigned* bar, unsigned x, volatile LAS unsigned* st, bool leader_thread) {
    asm volatile("s_waitcnt vmcnt(0)" ::: "memory");
    __syncthreads();
    if (leader_thread) {
        __builtin_amdgcn_s_waitcnt(0);
        unsigned nloc = st[0], nx = st[1];
        if (nloc == 0u) { xcd_barrier_complete(bar, x, nloc, nx); st[0] = nloc; st[1] = nx; }
        const unsigned old = xb_add(&bar[XB_XSUB(x)], 1u);
        const unsigned gen = old / nloc;
        if (old + 1u == (gen + 1u) * nloc) {
            __builtin_amdgcn_fence(__ATOMIC_RELEASE, "agent");
            asm volatile("s_waitcnt vmcnt(0)" ::: "memory");
            const unsigned og = xb_add(&bar[XB_TOP], 1u);
            const unsigned tg = og / nx;
            if (og + 1u == (tg + 1u) * nx) xb_add(&bar[XB_TOPGEN], 1u);
            else XB_SPIN(xb_ld(&bar[XB_TOPGEN]) == tg, bar);
            __builtin_amdgcn_fence(__ATOMIC_ACQUIRE, "agent");
            xb_add(&bar[XB_XGEN(x)], 1u);
            asm volatile("s_waitcnt vmcnt(0)" ::: "memory");
        } else {
            XB_SPIN(xb_ld(&bar[XB_XGEN(x)]) == gen, bar);
            __builtin_amdgcn_fence(__ATOMIC_ACQUIRE, "agent");
            asm volatile("s_waitcnt vmcnt(0)" ::: "memory");
        }
    }
    __syncthreads();
}

__global__ void __launch_bounds__(512, 2) hybrid_fwd(Args A) {
    extern __shared__ __attribute__((aligned(16))) unsigned char lds_raw[];
    LAS unsigned char* lds = (LAS unsigned char*)lds_raw;
    cg::grid_group grid = cg::this_grid();
    const int G = gridDim.x;
    const int wave_s = __builtin_amdgcn_readfirstlane((int)threadIdx.x >> 6);
#define TID() (wave_s * 64 + lane_id_asm())
    GAS unsigned char* ws = (GAS unsigned char*)A.ws;
    bf16_t* hb = (bf16_t*)(ws + WS_HB); float* ssq = (float*)(ws + WS_SSQ);
    const float* tab = (const float*)(ws + WS_TAB);

    volatile LAS unsigned* bst = (volatile LAS unsigned*)(lds + LDS_BYTES - 16);
    if (threadIdx.x < 2) bst[threadIdx.x] = 0u;
    __syncthreads();
    GAS unsigned* barw = (GAS unsigned*)(ws + WS_BAR);
    const unsigned bxcc = xcd_barrier_post((unsigned*)barw, bst).x;
#define GRID_BAR() do { asm volatile("" : "+s"(barw)); xcd_barrier((unsigned*)barw, bxcc, bst, lane_id_asm() == 0 && wave_s == 0); } while (0)
    prologue(A, lds, TID(), G);
    if (A.out == nullptr) grid.sync();
    GRID_BAR();

    for (int layer = 0; layer < 4; ++layer) {
        for (int sub = 0; sub < 3; ++sub) {
            asm volatile("" : "+s"(ws));
            int z = 0; asm volatile("" : "+s"(z));
            int bid = blockIdx.x, Gv = gridDim.x; asm volatile("" : "+s"(bid), "+s"(Gv));
            pg8::Gemm gres; float scale;
            if (sub != 1) {
                const int f = layer * 2 + (sub >> 1);
                const bf16_t* wgu = (const bf16_t*)(ws + WS_FFN + (size_t)f * FFN_STRIDE); const bf16_t* wd = (const bf16_t*)(ws + WS_FFN + (size_t)f * FFN_STRIDE + WGU_BYTES);
                bf16_t* mid = (bf16_t*)(ws + WS_MID);
                { pg8::Gemm g{hb, wgu, MTOK, NGU, DM, DM, DM, 0}; pg8::StaticOrder S; S.init(MTOK, NGU, Gv, bid);
                  EpiGU E{mid, ssq}; pg8::gemm_phase<EpiGU>(lds, g, S, E, TID()); }
                GRID_BAR();
                gres = pg8::Gemm{mid, wd, MTOK, DM, DFF, DFF, DFF, 0}; scale = 0.5f;
            } else if ((layer & 1) == 0) {
                const int e = layer >> 1;
                const bf16_t* win = (const bf16_t*)(ws + WS_EVEN + (size_t)e * EVEN_STRIDE); const bf16_t* wout = (const bf16_t*)(ws + WS_EVEN + (size_t)e * EVEN_STRIDE + EVEN_WIN_BYTES);
                bf16_t* qb = (bf16_t*)(ws + WS_Q); bf16_t* kvb = (bf16_t*)(ws + WS_KV); bf16_t* glu = (bf16_t*)(ws + WS_GLU); bf16_t* cat = (bf16_t*)(ws + WS_CAT);
                { pg8::Gemm g{hb, win, MTOK, EVEN_IN, DM, DM, DM, 0}; pg8::StaticOrder S; S.init(MTOK, EVEN_IN, Gv, bid);
                  EpiEvenIn E{qb, kvb, glu, ssq}; pg8::gemm_phase<EpiEvenIn>(lds, g, S, E, TID()); }
                GRID_BAR();
                attn_phase(lds, qb, kvb, cat, tab + 2048, A.in[12 + z] + e * 8, TID(), Gv);
                conv_phase(lds, glu, cat, A.in[13 + z] + (size_t)e * 31 * 512, A.in[14 + z] + e * 512, A.in[15 + z] + e * 512, A.in[16 + z] + e * 512, TID(), Gv);
                GRID_BAR();
                gres = pg8::Gemm{cat, wout, MTOK, DM, DM, DM, DM, 0}; scale = 1.0f;
            } else {
                const int o = layer >> 1;
                const bf16_t* win = (const bf16_t*)(ws + WS_ODD + (size_t)o * ODD_STRIDE); const bf16_t* wout = (const bf16_t*)(ws + WS_ODD + (size_t)o * ODD_STRIDE + 4 * MiB);
                const bf16_t* wgate = (const bf16_t*)(ws + WS_ODD + (size_t)o * ODD_STRIDE + 6 * MiB);
                bf16_t* gate = (bf16_t*)(ws + WS_GATE); bf16_t* urec = (bf16_t*)(ws + WS_UREC); bf16_t* xc = (bf16_t*)(ws + WS_XC); bf16_t* av = (bf16_t*)(ws + WS_A);
                { pg8::Gemm g{hb, win, MTOK, 2048, DM, DM, DM, 0}; pg8::StaticOrder S; S.init(MTOK, 2048, Gv, bid);
                  EpiOddIn E{gate, urec, ssq}; pg8::gemm_phase<EpiOddIn>(lds, g, S, E, TID()); }
                GRID_BAR();
                conv4_phase(urec, xc, A.in[19 + z] + (size_t)o * 4 * DM, A.in[20 + z] + o * DM, TID(), Gv);
                GRID_BAR();
                { pg8::Gemm g{xc, wgate, MTOK, 2048, 128, DM, 128, 256}; pg8::StaticOrder S; S.init(MTOK, 2048, Gv, bid);
                  EpiLru E{xc, av, urec, A.in[22 + z] + o * DM, A.in[24 + z] + o * DM, tab + o * DM}; pg8::gemm_phase<EpiLru>(lds, g, S, E, TID()); }
                GRID_BAR();
                scan_phase(lds, av, urec, gate, xc, TID(), Gv);
                GRID_BAR();
                gres = pg8::Gemm{xc, wout, MTOK, DM, DM, DM, DM, 0}; scale = 1.0f;
            }
            { pg8::StaticOrder S; S.init(MTOK, DM, Gv, bid);
              EpiRes E{hb, ssq, scale}; pg8::gemm_phase<EpiRes>(lds, gres, S, E, TID()); }
            GRID_BAR();
        }
    }
    final_norm(hb, A.out, A.in[27], TID(), G);
}

extern "C" void kernel_launch(void* const* d_in, const int* in_sizes, int n_in, void* d_out, int out_size, void* d_ws, size_t ws_size, hipStream_t stream) {
    static int grid = 0;
    if (grid == 0) {
        if (n_in != 28 || in_sizes[0] != MTOK * DM || out_size != MTOK * DM || ws_size < WS_NEED) {
            fprintf(stderr, "kernel_launch: unexpected shapes (n_in %d, in0 %d, out %d, ws %zu; need ws >= %zu)\n", n_in, n_in > 0 ? in_sizes[0] : -1, out_size, ws_size, (size_t)WS_NEED); grid = -1; return; }
        int dev = 0, cus = 0, per_cu = 0;
        hipGetDevice(&dev); hipDeviceGetAttribute(&cus, hipDeviceAttributeMultiprocessorCount, dev);
        if (hipFuncSetAttribute((const void*)hybrid_fwd, hipFuncAttributeMaxDynamicSharedMemorySize, LDS_BYTES) != hipSuccess) { fprintf(stderr, "kernel_launch: hipFuncSetAttribute failed\n"); grid = -1; return; }
        if (hipOccupancyMaxActiveBlocksPerMultiprocessor(&per_cu, (const void*)hybrid_fwd, 512, LDS_BYTES) != hipSuccess || per_cu < 1) { fprintf(stderr, "kernel_launch: occupancy query gave %d\n", per_cu); per_cu = 1; }
        (void)hipGetLastError();
        grid = cus * per_cu;
    }
    if (grid < 0) return;
    Args a{};
    for (int i = 0; i < 28; ++i) a.in[i] = (const float*)d_in[i];
    a.out = (float*)d_out; a.ws = (unsigned char*)d_ws;
    if (hipMemsetAsync((char*)d_ws + WS_BAR, 0, XCD_BAR_WORDS * 4, stream) != hipSuccess) { fprintf(stderr, "kernel_launch: memset failed\n"); return; }
    void* args[] = {&a};
    hipError_t e = hipLaunchCooperativeKernel((const void*)hybrid_fwd, dim3(grid), dim3(512), args, LDS_BYTES, stream);
    if (e != hipSuccess) fprintf(stderr, "kernel_launch: cooperative launch failed: %s (grid %d)\n", hipGetErrorString(e), grid);
}
```
